# Optimizing an MI355X kernel written in HIP

```python
import numpy as np
import jax, jax.numpy as jnp
from jax import lax


D_MODEL = 1024
BATCH = 16
SEQ = 2048
DEPTH = 4

GRID_W = 64
CTX_LEN = 256
N_MIXERS = 3
EPS = 1e-6
NEG_INF = -1e30

NA_HEADS = 16
NA_HEAD_DIM = D_MODEL // NA_HEADS
NA_WIN_ROWS = 8
NA_WIN_COLS = 16
NA_QBLOCK_W = 16
NA_KBLOCK_W = 2 * NA_WIN_COLS

GMLP_CHUNK = 128
GMLP_WIDTH = D_MODEL
GMLP_GROUPS = 8

POOL_WINDOWS = (2, 4, 8, 16)
POOL_GROUP = D_MODEL // len(POOL_WINDOWS)

FFN_HIDDEN = -(-8 * D_MODEL // (3 * 256)) * 256

N_A = len(range(0, DEPTH, N_MIXERS))
N_B = len(range(1, DEPTH, N_MIXERS))
N_C = len(range(2, DEPTH, N_MIXERS))

kernel_name = 'hybrid_na_gmlp_pool_prefix_dit'


def rmsnorm(x, g):
    xf = x.astype(jnp.float32)
    y = xf * lax.rsqrt(jnp.mean(xf * xf, axis=-1, keepdims=True) + EPS)
    return (y * g.astype(jnp.float32)).astype(x.dtype)


def layernorm(x, g, b):
    xf = x.astype(jnp.float32)
    mu = jnp.mean(xf, axis=-1, keepdims=True)
    xc = xf - mu
    var = jnp.mean(xc * xc, axis=-1, keepdims=True)
    return (xc * lax.rsqrt(var + EPS) * g.astype(jnp.float32) + b.astype(jnp.float32)).astype(x.dtype)


def swiglu(h, w_gate, w_up, w_down):
    return (jax.nn.silu(h @ w_gate) * (h @ w_up)) @ w_down


def _heads(t):
    B, L, _ = t.shape
    return t.reshape(B, L, NA_HEADS, NA_HEAD_DIM).transpose(0, 2, 1, 3)


def _na_column_tables():
    n_cb = GRID_W // NA_QBLOCK_W
    qcol = np.arange(GRID_W).reshape(n_cb, NA_QBLOCK_W)
    kc0 = np.clip(np.arange(n_cb) * NA_QBLOCK_W - NA_WIN_COLS // 2, 0, GRID_W - NA_KBLOCK_W)
    kcol = kc0[:, None] + np.arange(NA_KBLOCK_W)
    cstart = np.clip(qcol - NA_WIN_COLS // 2, 0, GRID_W - NA_WIN_COLS)
    col_ok = (kcol[:, None, :] >= cstart[..., None]) & (kcol[:, None, :] < cstart[..., None] + NA_WIN_COLS)
    dc_idx = np.clip(kcol[:, None, :] - qcol[:, :, None] + NA_WIN_COLS - 1, 0, 2 * NA_WIN_COLS - 2)
    return kcol, col_ok, dc_idx


def na_mixer(h, hc, w_qkv, w_o, q_g, k_g, rpb, ctx_out):
    B, S, _ = h.shape
    rows = S // GRID_W
    rw = min(NA_WIN_ROWS, rows)
    n_cb = GRID_W // NA_QBLOCK_W
    H, hd, QB, KB = NA_HEADS, NA_HEAD_DIM, NA_QBLOCK_W, NA_KBLOCK_W
    scale = hd ** -0.5
    kcol, col_ok, dc_idx = _na_column_tables()

    q, k, v = jnp.split(h @ w_qkv, 3, axis=-1)
    q, k, v = rmsnorm(_heads(q), q_g), rmsnorm(_heads(k), k_g), _heads(v)
    qc, kc, vc = jnp.split(hc @ w_qkv, 3, axis=-1)
    kc, vc = rmsnorm(_heads(kc), k_g), _heads(vc)

    kgrid = k.reshape(B, H, rows, GRID_W, hd)
    vgrid = v.reshape(B, H, rows, GRID_W, hd)
    q_rows = jnp.moveaxis(q.reshape(B, H, rows, GRID_W, hd), 2, 0)
    rpb_c = rpb[:, :, dc_idx]
    nloc = rw * KB
    ok = np.broadcast_to(col_ok[:, :, None, :], (n_cb, QB, rw, KB)).reshape(n_cb, QB, nloc)

    def row_block(args):
        q_r, r = args
        rs = jnp.clip(r - rw // 2, 0, rows - rw)

        def gather(t):
            t = lax.dynamic_slice_in_dim(t, rs, rw, axis=2)
            t = jnp.take(t, kcol, axis=3)
            return t.transpose(0, 1, 3, 2, 4, 5).reshape(B, H, n_cb, nloc, hd)

        kb, vb = gather(kgrid), gather(vgrid)
        qb = q_r.reshape(B, H, n_cb, QB, hd)
        dr = rs + jnp.arange(rw) - r + NA_WIN_ROWS - 1
        bias = jnp.take(rpb_c, dr, axis=1).transpose(0, 2, 3, 1, 4).reshape(H, n_cb, QB, nloc)
        s_loc = jnp.einsum('bhjqd,bhjkd->bhjqk', qb, kb).astype(jnp.float32) * scale + bias.astype(jnp.float32)
        s_loc = jnp.where(ok, s_loc, NEG_INF)
        s_ctx = jnp.einsum('bhjqd,bhkd->bhjqk', qb, kc).astype(jnp.float32) * scale
        p = jax.nn.softmax(jnp.concatenate([s_loc, s_ctx], axis=-1), axis=-1).astype(v.dtype)
        o = (jnp.einsum('bhjqk,bhjkd->bhjqd', p[..., :nloc], vb)
             + jnp.einsum('bhjqk,bhkd->bhjqd', p[..., nloc:], vc))
        return o.reshape(B, H, GRID_W, hd)

    o = lax.map(row_block, (q_rows, jnp.arange(rows)))
    y = o.transpose(1, 0, 3, 2, 4).reshape(B, S, H * hd) @ w_o
    if not ctx_out:
        return y, None
    qc = rmsnorm(_heads(qc), q_g)
    sc = jnp.einsum('bhqd,bhkd->bhqk', qc, kc).astype(jnp.float32) * scale
    pc = jax.nn.softmax(sc, axis=-1).astype(vc.dtype)
    oc = jnp.einsum('bhqk,bhkd->bhqd', pc, vc)
    Bc, _, Lc, _ = oc.shape
    yc = oc.transpose(0, 2, 1, 3).reshape(Bc, Lc, H * hd) @ w_o
    return y, yc


def gmlp_mixer(h, w_in, b_in, ln_g, ln_b, w_s, b_s, w_out):
    B, L, _ = h.shape
    z = jax.nn.gelu(h @ w_in + b_in)
    u, v = jnp.split(z, 2, axis=-1)
    v = layernorm(v, ln_g, ln_b)
    vg = v.reshape(B, L // GMLP_CHUNK, GMLP_CHUNK, GMLP_GROUPS, GMLP_WIDTH // GMLP_GROUPS)
    mixed = jnp.einsum('gpq,bnqgd->bnpgd', w_s, vg) + b_s.T[None, None, :, :, None]
    return (u * mixed.reshape(B, L, GMLP_WIDTH)) @ w_out


def pool_mixer(h, w_pool, pool_scale):
    B, L, _ = h.shape
    t = np.arange(L)
    outs = []
    for g, w in enumerate(POOL_WINDOWS):
        hg = h[..., g * POOL_GROUP:(g + 1) * POOL_GROUP].astype(jnp.float32)
        cs = jnp.pad(jnp.cumsum(hg, axis=1), ((0, 0), (1, 0), (0, 0)))
        lo = np.clip(t - w // 2, 0, L)
        hi = np.clip(t - w // 2 + w, 0, L)
        cnt = (hi - lo).astype(np.float32)[:, None]
        mean = (jnp.take(cs, hi, axis=1) - jnp.take(cs, lo, axis=1)) / cnt
        outs.append(jnp.einsum('bld,de->ble', (mean - hg).astype(h.dtype), w_pool[g]))
    return jnp.concatenate(outs, axis=-1) * pool_scale


def setup_inputs(seed: int = 0) -> dict:
    key = jax.random.key(seed)
    ks = jax.random.split(key, 26)
    D, F, H, hd = D_MODEL, FFN_HIDDEN, NA_HEADS, NA_HEAD_DIM

    def nrm(k, shape, s):
        return jax.random.normal(k, shape, jnp.float32) * s

    return {
        'x': nrm(ks[0], (BATCH, SEQ, D), 1.0),
        'c': nrm(ks[1], (BATCH, D), 1.0),
        'ctx': nrm(ks[2], (BATCH, CTX_LEN, D), 1.0),
        'c_ctx': nrm(ks[3], (D,), 1.0),
        'ada_w': nrm(ks[4], (DEPTH, D, 6 * D), 0.5 * D ** -0.5),
        'ada_b': nrm(ks[5], (DEPTH, 6 * D), 0.02),
        'norm1_g': 1.0 + nrm(ks[6], (DEPTH, D), 0.02),
        'norm2_g': 1.0 + nrm(ks[7], (DEPTH, D), 0.02),
        'ffn_w_gate': nrm(ks[8], (DEPTH, D, F), D ** -0.5),
        'ffn_w_up': nrm(ks[9], (DEPTH, D, F), D ** -0.5),
        'ffn_w_down': nrm(ks[10], (DEPTH, F, D), F ** -0.5),
        'na_w_qkv': nrm(ks[11], (N_A, D, 3 * D), D ** -0.5),
        'na_w_o': nrm(ks[12], (N_A, D, D), D ** -0.5),
        'na_q_norm': 1.0 + nrm(ks[13], (N_A, hd), 0.02),
        'na_k_norm': 1.0 + nrm(ks[14], (N_A, hd), 0.02),
        'na_rpb': nrm(ks[15], (N_A, H, 2 * NA_WIN_ROWS - 1, 2 * NA_WIN_COLS - 1), 0.1),
        'gm_w_in': nrm(ks[16], (N_B, D, 2 * GMLP_WIDTH), D ** -0.5),
        'gm_b_in': nrm(ks[17], (N_B, 2 * GMLP_WIDTH), 0.02),
        'gm_ln_g': 1.0 + nrm(ks[18], (N_B, GMLP_WIDTH), 0.02),
        'gm_ln_b': nrm(ks[19], (N_B, GMLP_WIDTH), 0.02),
        'gm_w_s': nrm(ks[20], (N_B, GMLP_GROUPS, GMLP_CHUNK, GMLP_CHUNK), GMLP_CHUNK ** -0.5),
        'gm_b_s': 1.0 + nrm(ks[21], (N_B, GMLP_GROUPS, GMLP_CHUNK), 0.02),
        'gm_w_out': nrm(ks[22], (N_B, GMLP_WIDTH, D), GMLP_WIDTH ** -0.5),
        'pool_w': nrm(ks[23], (N_C, len(POOL_WINDOWS), POOL_GROUP, POOL_GROUP), POOL_GROUP ** -0.5),
        'pool_scale': 1.0 + nrm(ks[24], (N_C, D), 0.02),
    }


def reference(x, c, ctx, c_ctx, ada_w, ada_b, norm1_g, norm2_g, ffn_w_gate, ffn_w_up, ffn_w_down,
              na_w_qkv, na_w_o, na_q_norm, na_k_norm, na_rpb,
              gm_w_in, gm_b_in, gm_ln_g, gm_ln_b, gm_w_s, gm_b_s, gm_w_out,
              pool_w, pool_scale):
    s_lat = jax.nn.silu(c)
    s_ctx = jax.nn.silu(c_ctx)
    xc = ctx
    for i in range(DEPTH):
        kind, j = i % N_MIXERS, i // N_MIXERS
        last = i == DEPTH - 1
        need_ctx = (not last) or kind == 0
        sh1, sc1, g1, sh2, sc2, g2 = jnp.split((s_lat @ ada_w[i] + ada_b[i])[:, None, :], 6, axis=-1)
        csh1, csc1, cg1, csh2, csc2, cg2 = jnp.split(s_ctx @ ada_w[i] + ada_b[i], 6, axis=-1)

        h = rmsnorm(x, norm1_g[i]) * (1.0 + sc1) + sh1
        hc = rmsnorm(xc, norm1_g[i]) * (1.0 + csc1) + csh1 if need_ctx else None
        if kind == 0:
            y, yc = na_mixer(h, hc, na_w_qkv[j], na_w_o[j], na_q_norm[j], na_k_norm[j], na_rpb[j],
                             ctx_out=not last)
        elif kind == 1:
            gp = (gm_w_in[j], gm_b_in[j], gm_ln_g[j], gm_ln_b[j], gm_w_s[j], gm_b_s[j], gm_w_out[j])
            y = gmlp_mixer(h, *gp)
            yc = gmlp_mixer(hc, *gp) if not last else None
        else:
            y = pool_mixer(h, pool_w[j], pool_scale[j])
            yc = pool_mixer(hc, pool_w[j], pool_scale[j]) if not last else None

        x = x + g1 * y
        h2 = rmsnorm(x, norm2_g[i]) * (1.0 + sc2) + sh2
        x = x + g2 * swiglu(h2, ffn_w_gate[i], ffn_w_up[i], ffn_w_down[i])
        if not last:
            xc = xc + cg1 * yc
            hc2 = rmsnorm(xc, norm2_g[i]) * (1.0 + csc2) + csh2
            xc = xc + cg2 * swiglu(hc2, ffn_w_gate[i], ffn_w_up[i], ffn_w_down[i])
    return x
```

```cpp
#include <hip/hip_runtime.h>
#include <hip/hip_cooperative_groups.h>
#include <cstdio>
#include <cstdint>
namespace cg = cooperative_groups;

#ifndef SKIP_OP
#define SKIP_OP 99
#endif
#ifndef MK_MULTI
#define MK_MULTI 0
#endif

#define LAS __attribute__((address_space(3)))
typedef unsigned short bf16_t;
typedef short bf16x8 __attribute__((ext_vector_type(8)));
typedef short s16x4 __attribute__((ext_vector_type(4)));
typedef float f32x4 __attribute__((ext_vector_type(4)));
typedef float f32x2 __attribute__((ext_vector_type(2)));
typedef unsigned u32x4 __attribute__((ext_vector_type(4)));
typedef unsigned u32x2 __attribute__((ext_vector_type(2)));

constexpr int D = 1024, NB = 16, SEQ = 2048, CTX = 256, ML = NB * SEQ, MC = NB * CTX, MT = ML + MC, FF = 2816, NH = 16, HD = 64;
constexpr int MODW = 6 * D;
constexpr float EPS = 1e-6f, LOG2E = 1.4426950408889634f;
constexpr float QSCALE = 0.125f * LOG2E;
constexpr int LDS_BYTES = 155648;

constexpr size_t MiB = 1u << 20;
constexpr size_t WS_MOD = 0;
constexpr size_t WS_STATS = 2 * MiB;
constexpr size_t WS_WQKV = 7 * MiB;
constexpr size_t WS_WO = 19 * MiB;
constexpr size_t WS_WGU = 23 * MiB;
constexpr size_t WS_WDN = 67 * MiB;
constexpr size_t WS_WIN = 89 * MiB;
constexpr size_t WS_WOUT = 93 * MiB;
constexpr size_t WS_WPOOL = 95 * MiB;
constexpr size_t WS_XCTX = 96 * MiB;
constexpr size_t WS_H = 112 * MiB;
constexpr size_t WS_O = 184 * MiB;
constexpr size_t WS_BIG = 256 * MiB;
constexpr size_t WS_END = 472 * MiB;

__device__ __forceinline__ unsigned cvt_pk_bf16(float lo, float hi) { unsigned r; asm volatile("v_cvt_pk_bf16_f32 %0, %1, %2" : "=v"(r) : "v"(lo), "v"(hi)); return r; }
__device__ __forceinline__ float bf_lo(unsigned u) { return __uint_as_float(u << 16); }
__device__ __forceinline__ float bf_hi(unsigned u) { return __uint_as_float(u & 0xffff0000u); }
__device__ __forceinline__ float wave_sum(float v) {
#pragma unroll
    for (int o = 1; o < 64; o <<= 1) v += __shfl_xor(v, o);
    return v;
}
__device__ __forceinline__ float fast_rcp(float x) { return __builtin_amdgcn_rcpf(x); }
__device__ __forceinline__ float fast_exp2(float x) { return __builtin_amdgcn_exp2f(x); }
__device__ __forceinline__ float silu_f(float x) { return x * fast_rcp(1.0f + fast_exp2(-LOG2E * x)); }
__device__ __forceinline__ float gelu_tanh_f(float x) {
    const float y = 0.7978845608028654f * (x + 0.044715f * x * x * x);
    return x * fast_rcp(1.0f + fast_exp2(-2.0f * LOG2E * y));
}

namespace pg8 {
constexpr int BM = 256, BK = 64, HALF = 128, HTB = HALF * BK * 2, STAGE_BYTES = 8 * HTB, NXCD = 8, WGM = 8;
__host__ __device__ __forceinline__ int lds_byte(int r, int c) { const int st = (r >> 4) * 2 + (c >> 5), rr = r & 15, cc = c & 31, ob = rr * 64 + cc * 2; return st * 1024 + (ob ^ (((ob >> 9) & 1) << 5)); }
__host__ __device__ __forceinline__ void stage_rc(int b, int& R, int& C) { const int st = b / 1024, sb = b % 1024, swz = sb ^ (((sb >> 9) & 1) << 5); R = (st >> 1) * 16 + swz / 64; C = (st & 1) * 32 + (swz % 64) / 2; }
__host__ __device__ __forceinline__ int perm32(int rho) { const int n = rho >> 4, i = rho & 15; return 8 * (i >> 2) + 4 * n + (i & 3); }

struct Unit { int pm, pn, k0, nt, split; };
struct Gemm { const bf16_t* A; const bf16_t* Bt; int M, N, K, lda, a_pn_off; };

struct StaticOrder {
    int nM, nN, nwg, G, c, ntf, nx;
    __device__ void init(int M, int N, int K, int G_, int c_, int Mextra = 0) { nM = M / BM; nN = N / BM; nwg = nM * nN; G = G_; c = c_; ntf = K / BK; nx = (Mextra / BM) * nN * 4; }
    __device__ bool next(int i, Unit& u) const {
        const long L = (long)i * G + c;
        if (L >= nwg) { const int e = (int)(L - nwg); if (e >= nx) return false;
            const int q = e & 3, tile = e >> 2, base = (ntf >> 2) & ~1, rem2 = (ntf - 4 * base) >> 1;
            u.pm = nM + tile / nN; u.pn = tile % nN; u.k0 = q * base + 2 * (q < rem2 ? q : rem2); u.nt = base + (q < rem2 ? 2 : 0); u.split = q + 1; return true; }
        int wgid = (int)L; { const int q = nwg / NXCD, r = nwg % NXCD, xcd = wgid % NXCD, off = wgid / NXCD; wgid = (xcd < r ? xcd * (q + 1) : r * (q + 1) + (xcd - r) * q) + off; }
        const int nig = WGM * nN, gid = wgid / nig, fm = gid * WGM, gsz = (nM - fm) < WGM ? (nM - fm) : WGM;
        u.pm = fm + ((wgid % nig) % gsz); u.pn = (wgid % nig) / gsz; u.k0 = 0; u.nt = ntf; u.split = 0; return true;
    }
};

template <class Epi>
__device__ __forceinline__ void gemm_phase(LAS unsigned char* lds, const Gemm g, const StaticOrder& S, const Epi& E, const int tid) {
    const int wid = __builtin_amdgcn_readfirstlane(tid >> 6), lane = tid & 63, wr = wid >> 2, wc = wid & 3, fr = lane & 15, fq = lane >> 4;
    const int K = g.K, lda = g.lda;
    unsigned voffA[2], voffB[2];
#pragma unroll
    for (int i = 0; i < 2; ++i) { int R, C; stage_rc(tid * 16 + i * 8192, R, C); const int Rb = Epi::PERM ? ((R & ~31) + perm32(R & 31)) : R;
        voffA[i] = (unsigned)(R * lda + C) * 2u; voffB[i] = (unsigned)(Rb * K + C) * 2u; }
    const size_t kstep = (size_t)(BK * 2);
    const size_t hstepA = (size_t)HALF * lda * 2, hstepB = (size_t)HALF * K * 2;
    const size_t tstepA = 2 * hstepA, tstepB = 2 * hstepB;
    const unsigned ldsw = (unsigned)wid * 1024u;
    const int aoff = lds_byte(wr * 64 + fr, fq * 8), boff = lds_byte(wc * 32 + fr, fq * 8);
#define PG8_SA(b, h) (((b) * 2 + (h)) * HTB)
#define PG8_SB(b, h) ((4 + (b) * 2 + (h)) * HTB)
#define PG8_STAGE(bufoff, gbase, voff) do { _Pragma("unroll") for (int _i = 0; _i < 2; ++_i) \
        __builtin_amdgcn_global_load_lds((const unsigned*)((const char*)(gbase) + (voff)[_i]), (LAS unsigned*)(lds + (bufoff) + ldsw + _i * 8192), 16, 0, 0); } while (0)
#define PG8_LDA(dst, b, h) do { _Pragma("unroll") for (int m = 0; m < 4; ++m) _Pragma("unroll") for (int k = 0; k < 2; ++k) dst[m][k] = *(const LAS bf16x8*)(lds + PG8_SA(b, h) + aoff + m * 2048 + k * 1024); } while (0)
#define PG8_LDB(dst, b, h) do { _Pragma("unroll") for (int n = 0; n < 2; ++n) _Pragma("unroll") for (int k = 0; k < 2; ++k) dst[n][k] = *(const LAS bf16x8*)(lds + PG8_SB(b, h) + boff + n * 2048 + k * 1024); } while (0)
#define PG8_MMA(ai, bj, At, Bt) do { __builtin_amdgcn_s_setprio(1); _Pragma("unroll") for (int m = 0; m < 4; ++m) _Pragma("unroll") for (int n = 0; n < 2; ++n) _Pragma("unroll") for (int k = 0; k < 2; ++k) \
        acc[ai][bj][m][n] = __builtin_amdgcn_mfma_f32_16x16x32_bf16(Bt[n][k], At[m][k], acc[ai][bj][m][n], 0, 0, 0); __builtin_amdgcn_s_setprio(0); } while (0)
#define PG8_WAIT_V(n) asm volatile("s_waitcnt vmcnt(" #n ")" ::: "memory")
#define PG8_WAIT_L(n) asm volatile("s_waitcnt lgkmcnt(" #n ")" ::: "memory")
#define PG8_BAR __builtin_amdgcn_s_barrier()
#define PG8_SCHED __builtin_amdgcn_sched_barrier(0)
    Unit cur, nxt; int ui = 0;
    if (!S.next(0, cur)) return;
    f32x4 acc[2][2][4][2];
#pragma unroll
    for (int a = 0; a < 2; ++a)
#pragma unroll
        for (int b = 0; b < 2; ++b)
#pragma unroll
            for (int m = 0; m < 4; ++m)
#pragma unroll
                for (int n = 0; n < 2; ++n) acc[a][b][m][n] = (f32x4){0.f, 0.f, 0.f, 0.f};
    bf16x8 At[4][2], B0[2][2], B1[2][2];
    const char* cA = (const char*)g.A + (size_t)cur.pm * tstepA + (size_t)cur.pn * g.a_pn_off + (size_t)cur.k0 * kstep; const char* cB = (const char*)g.Bt + (size_t)cur.pn * tstepB + (size_t)cur.k0 * kstep;
    PG8_STAGE(PG8_SB(0, 0), cB, voffB); PG8_STAGE(PG8_SB(0, 1), cB + hstepB, voffB); PG8_STAGE(PG8_SA(0, 0), cA, voffA); PG8_STAGE(PG8_SA(0, 1), cA + hstepA, voffA);
    if (wr == 1) PG8_BAR;
    PG8_WAIT_V(2); PG8_BAR;
    PG8_STAGE(PG8_SB(1, 0), cB + kstep, voffB); PG8_STAGE(PG8_SA(1, 0), cA + kstep, voffA); PG8_STAGE(PG8_SB(1, 1), cB + hstepB + kstep, voffB);
    PG8_WAIT_V(6); PG8_BAR;
    for (;;) {
        const bool has_next = S.next(ui + 1, nxt);
        const char* nA = has_next ? (const char*)g.A + (size_t)nxt.pm * tstepA + (size_t)nxt.pn * g.a_pn_off + (size_t)nxt.k0 * kstep : cA; const char* nB = has_next ? (const char*)g.Bt + (size_t)nxt.pn * tstepB + (size_t)nxt.k0 * kstep : cB;
        const int nt = cur.nt;
        for (int t = 0; t < nt; t += 2) {
            const bool last = (t == nt - 2);
            const char* a1 = cA + (size_t)(t + 1) * kstep;
            const char* a2 = last ? nA : cA + (size_t)(t + 2) * kstep; const char* b2 = last ? nB : cB + (size_t)(t + 2) * kstep;
            const char* a3 = a2 + kstep; const char* b3 = b2 + kstep;
            PG8_LDB(B0, 0, 0); PG8_LDB(B1, 0, 1); PG8_SCHED; PG8_LDA(At, 0, 0); PG8_STAGE(PG8_SA(1, 1), a1 + hstepA, voffA);
            PG8_WAIT_V(8); PG8_WAIT_L(0); PG8_BAR; PG8_MMA(0, 0, At, B0); PG8_MMA(0, 1, At, B1); PG8_BAR; PG8_SCHED;
            PG8_LDA(At, 0, 1); PG8_STAGE(PG8_SB(0, 0), b2, voffB); PG8_STAGE(PG8_SB(0, 1), b2 + hstepB, voffB); PG8_STAGE(PG8_SA(0, 0), a2, voffA);
            PG8_WAIT_V(8); PG8_WAIT_L(0); PG8_BAR; PG8_MMA(1, 0, At, B0); PG8_MMA(1, 1, At, B1); PG8_BAR; PG8_SCHED;
            PG8_LDB(B0, 1, 0); PG8_LDB(B1, 1, 1); PG8_SCHED; PG8_LDA(At, 1, 0); PG8_STAGE(PG8_SA(0, 1), a2 + hstepA, voffA);
            PG8_WAIT_V(8); PG8_WAIT_L(0); PG8_BAR; PG8_MMA(0, 0, At, B0); PG8_MMA(0, 1, At, B1); PG8_BAR; PG8_SCHED;
            PG8_LDA(At, 1, 1); PG8_STAGE(PG8_SB(1, 0), b3, voffB); PG8_STAGE(PG8_SB(1, 1), b3 + hstepB, voffB); PG8_STAGE(PG8_SA(1, 0), a3, voffA);
            PG8_WAIT_V(8); PG8_WAIT_L(0); PG8_BAR; PG8_MMA(1, 0, At, B0); PG8_MMA(1, 1, At, B1); PG8_BAR; PG8_SCHED;
        }
        if (wr == 0) PG8_BAR;
        E(acc, cur, wr, wc, fr, fq);
        if (!has_next) break;
#pragma unroll
        for (int a = 0; a < 2; ++a)
#pragma unroll
            for (int b = 0; b < 2; ++b)
#pragma unroll
                for (int m = 0; m < 4; ++m)
#pragma unroll
                    for (int n = 0; n < 2; ++n) acc[a][b][m][n] = (f32x4){0.f, 0.f, 0.f, 0.f};
        cur = nxt; cA = nA; cB = nB; ++ui;
        if (wr == 1) PG8_BAR;
    }
    PG8_WAIT_V(0);
    PG8_BAR;
#undef PG8_SA
#undef PG8_SB
#undef PG8_STAGE
#undef PG8_LDA
#undef PG8_LDB
#undef PG8_MMA
#undef PG8_WAIT_V
#undef PG8_WAIT_L
#undef PG8_BAR
#undef PG8_SCHED
}
}
using pg8::Unit;

struct EpiQKV {
    static constexpr bool PERM = true;
    bf16_t* O; const float* qg; const float* kg;
    __device__ __forceinline__ void operator()(const f32x4 (&acc)[2][2][4][2], const Unit& u, int wr, int wc, int fr, int fq) const {
        const int kind = u.pn >> 2;
        const int colbase = u.pn * 256 + wc * 64 + 8 * fq;
        f32x4 gv[2][2];
#pragma unroll
        for (int bj = 0; bj < 2; ++bj)
#pragma unroll
            for (int n = 0; n < 2; ++n) {
                gv[bj][n] = (f32x4){1.f, 1.f, 1.f, 1.f};
                if (kind < 2) gv[bj][n] = *(const f32x4*)((kind == 0 ? qg : kg) + 32 * bj + 8 * fq + 4 * n);
            }
        const float post = kind == 0 ? QSCALE : 1.0f;
#pragma unroll
        for (int ai = 0; ai < 2; ++ai)
#pragma unroll
            for (int m = 0; m < 4; ++m) {
                const int row = u.pm * 256 + ai * 128 + wr * 64 + m * 16 + fr;
                f32x4 v[2][2];
#pragma unroll
                for (int bj = 0; bj < 2; ++bj)
#pragma unroll
                    for (int n = 0; n < 2; ++n) v[bj][n] = acc[ai][bj][m][n];
                if (kind < 2) {
                    float ss = 0.f;
#pragma unroll
                    for (int bj = 0; bj < 2; ++bj)
#pragma unroll
                        for (int n = 0; n < 2; ++n) ss += (v[bj][n][0] * v[bj][n][0] + v[bj][n][1] * v[bj][n][1]) + (v[bj][n][2] * v[bj][n][2] + v[bj][n][3] * v[bj][n][3]);
                    ss += __shfl_xor(ss, 16); ss += __shfl_xor(ss, 32);
                    const float rs = __builtin_amdgcn_rsqf(ss * (1.0f / 64.0f) + EPS) * post;
#pragma unroll
                    for (int bj = 0; bj < 2; ++bj)
#pragma unroll
                        for (int n = 0; n < 2; ++n) v[bj][n] = v[bj][n] * rs * gv[bj][n];
                }
                bf16_t* rowp = O + (size_t)row * 3072 + colbase;
#pragma unroll
                for (int bj = 0; bj < 2; ++bj) {
                    u32x4 w; w.x = cvt_pk_bf16(v[bj][0][0], v[bj][0][1]); w.y = cvt_pk_bf16(v[bj][0][2], v[bj][0][3]); w.z = cvt_pk_bf16(v[bj][1][0], v[bj][1][1]); w.w = cvt_pk_bf16(v[bj][1][2], v[bj][1][3]);
                    *(u32x4*)(rowp + 32 * bj) = w; }
            }
    }
};
struct EpiResid {
    static constexpr bool PERM = false;
    const float* base_lat; const float* base_ctx; float* out_lat; float* out_ctx; const float* mod; const float* cscale; float* part;
    __device__ __forceinline__ void operator()(const f32x4 (&acc)[2][2][4][2], const Unit& u, int wr, int wc, int fr, int fq) const {
        const bool lat = u.pm < (ML / 256); const int bidx = lat ? (u.pm >> 3) : NB;
        const float* base = lat ? base_lat : base_ctx; float* out = lat ? out_lat : out_ctx;
        const float* gp = mod + (size_t)bidx * MODW;
        const int col0 = u.pn * 256 + wc * 32 + 4 * fq;
        f32x4 gt[2][2];
#pragma unroll
        for (int bj = 0; bj < 2; ++bj)
#pragma unroll
            for (int n = 0; n < 2; ++n) { gt[bj][n] = *(const f32x4*)(gp + col0 + bj * 128 + n * 16); if (cscale) gt[bj][n] = gt[bj][n] * *(const f32x4*)(cscale + col0 + bj * 128 + n * 16); }
        if (u.split) {
            float* pb = part + (size_t)(u.split - 1) * MC * D - (size_t)ML * D;
#pragma unroll
            for (int ai = 0; ai < 2; ++ai)
#pragma unroll
                for (int m = 0; m < 4; ++m) {
                    float* op = pb + (size_t)(u.pm * 256 + ai * 128 + wr * 64 + m * 16 + fr) * D + col0;
#pragma unroll
                    for (int bj = 0; bj < 2; ++bj)
#pragma unroll
                        for (int n = 0; n < 2; ++n) *(f32x4*)(op + bj * 128 + n * 16) = gt[bj][n] * acc[ai][bj][m][n];
                }
            return;
        }
#pragma unroll
        for (int ai = 0; ai < 2; ++ai)
#pragma unroll
            for (int m = 0; m < 4; ++m) {
                const size_t off = (size_t)(u.pm * 256 + ai * 128 + wr * 64 + m * 16 + fr) * D + col0;
#pragma unroll
                for (int bj = 0; bj < 2; ++bj)
#pragma unroll
                    for (int n = 0; n < 2; ++n) { const f32x4 bs = *(const f32x4*)(base + off + bj * 128 + n * 16); *(f32x4*)(out + off + bj * 128 + n * 16) = bs + gt[bj][n] * acc[ai][bj][m][n]; }
                asm volatile("" ::: "memory");
            }
    }
};
struct EpiSwiGLU {
    static constexpr bool PERM = true;
    bf16_t* G;
    __device__ __forceinline__ void operator()(const f32x4 (&acc)[2][2][4][2], const Unit& u, int wr, int wc, int fr, int fq) const {
        const int col = u.pn * 128 + wc * 32 + 8 * fq;
#pragma unroll
        for (int ai = 0; ai < 2; ++ai)
#pragma unroll
            for (int m = 0; m < 4; ++m) {
                const int row = u.pm * 256 + ai * 128 + wr * 64 + m * 16 + fr;
                float h[8];
#pragma unroll
                for (int n = 0; n < 2; ++n)
#pragma unroll
                    for (int e = 0; e < 4; ++e) h[4 * n + e] = silu_f(acc[ai][0][m][n][e]) * acc[ai][1][m][n][e];
                u32x4 w; w.x = cvt_pk_bf16(h[0], h[1]); w.y = cvt_pk_bf16(h[2], h[3]); w.z = cvt_pk_bf16(h[4], h[5]); w.w = cvt_pk_bf16(h[6], h[7]);
                *(u32x4*)(G + (size_t)row * FF + col) = w;
            }
    }
};
struct EpiGelu {
    static constexpr bool PERM = true;
    bf16_t* Z; const float* bias; float* stats;
    __device__ __forceinline__ void operator()(const f32x4 (&acc)[2][2][4][2], const Unit& u, int wr, int wc, int fr, int fq) const {
        const int col0 = u.pn * 256 + wc * 32 + 8 * fq;
        f32x4 bv[2][2];
#pragma unroll
        for (int bj = 0; bj < 2; ++bj)
#pragma unroll
            for (int n = 0; n < 2; ++n) bv[bj][n] = *(const f32x4*)(bias + col0 + bj * 128 + 4 * n);
#pragma unroll
        for (int ai = 0; ai < 2; ++ai)
#pragma unroll
            for (int m = 0; m < 4; ++m) {
                const int row = u.pm * 256 + ai * 128 + wr * 64 + m * 16 + fr;
                float s = 0.f, ss = 0.f;
#pragma unroll
                for (int bj = 0; bj < 2; ++bj) {
                    float h[8];
#pragma unroll
                    for (int n = 0; n < 2; ++n)
#pragma unroll
                        for (int e = 0; e < 4; ++e) { const float x = gelu_tanh_f(acc[ai][bj][m][n][e] + bv[bj][n][e]); h[4 * n + e] = x; s += x; ss += x * x; }
                    u32x4 w; w.x = cvt_pk_bf16(h[0], h[1]); w.y = cvt_pk_bf16(h[2], h[3]); w.z = cvt_pk_bf16(h[4], h[5]); w.w = cvt_pk_bf16(h[6], h[7]);
                    *(u32x4*)(Z + (size_t)row * 2048 + col0 + bj * 128) = w;
                }
                if (u.pn >= 4) {
                    s += __shfl_xor(s, 16); s += __shfl_xor(s, 32); ss += __shfl_xor(ss, 16); ss += __shfl_xor(ss, 32);
                    if (fq == 0) *(f32x2*)(stats + ((size_t)row * 16 + (u.pn - 4) * 4 + wc) * 2) = (f32x2){s, ss};
                }
            }
    }
};

struct Args {
    const float* in[25];
    float* out; unsigned char* ws;
    int ph_lo, ph_hi;
};
enum { I_X = 0, I_C, I_CTX, I_CCTX, I_ADAW, I_ADAB, I_N1G, I_N2G, I_WG, I_WU, I_WD, I_WQKV, I_WO, I_QN, I_KN, I_RPB, I_GWIN, I_GBIN, I_GLNG, I_GLNB, I_GWS, I_GBS, I_GWOUT, I_PW, I_PS };

__device__ __forceinline__ unsigned f2bf(float f) { unsigned u = __builtin_bit_cast(unsigned, f); return (u + 0x7fffu + ((u >> 16) & 1u)) >> 16; }
__device__ __forceinline__ unsigned pk2(float lo, float hi) { return f2bf(lo) | (f2bf(hi) << 16); }
__device__ __forceinline__ void p0_transpose_item(const float* W, int K, int N, bf16_t* WT, int mode, int row_off, LAS float* scr, int item, int lane) {
    const int nblk = N / 32, kb = item / nblk, nb = item % nblk, k0 = 64 * kb, n0 = 32 * nb;
#pragma unroll 8
    for (int i = 0; i < 32; ++i) { const int kk = 2 * i + (lane >> 5); scr[kk * 33 + (lane & 31)] = W[(size_t)(k0 + kk) * N + n0 + (lane & 31)]; }
    asm volatile("s_waitcnt lgkmcnt(0)" ::: "memory");
    int r0;
    if (mode == 0) r0 = row_off + n0;
    else if (mode == 1) { const int pn = n0 >> 8, lc = n0 & 255; r0 = pn * 256 + 128 * ((lc & 63) >> 5) + 32 * (lc >> 6); }
    else r0 = (n0 >> 7) * 256 + (n0 & 127) + row_off;
    const int c = lane & 7;
#pragma unroll
    for (int j = 0; j < 4; ++j) { const int n = (lane >> 3) + 8 * j; const LAS float* s = scr + (8 * c) * 33 + n;
        u32x4 o; o.x = pk2(s[0 * 33], s[1 * 33]); o.y = pk2(s[2 * 33], s[3 * 33]); o.z = pk2(s[4 * 33], s[5 * 33]); o.w = pk2(s[6 * 33], s[7 * 33]);
        *(u32x4*)(WT + (size_t)(r0 + n) * K + k0 + 8 * c) = o; }
    asm volatile("s_waitcnt lgkmcnt(0)" ::: "memory");
}

typedef const __attribute__((address_space(4))) Args* ArgsP;
__device__ __forceinline__ void p0_prologue(ArgsP ap, LAS unsigned char* lds, int G, int bid, const int tid) {
    const int lane = tid & 63, w = __builtin_amdgcn_readfirstlane(tid >> 6);
    unsigned char* ws = ap->ws;
    if (bid < 384) {
        LAS float* S17 = (LAS float*)lds; LAS float* RED = (LAS float*)(lds + 17 * 1024 * 4);
        for (int e = tid; e < 17 * 1024; e += 512) { const int b = e >> 10, k = e & 1023; const float x = b < 16 ? ap->in[I_C][b * 1024 + k] : ap->in[I_CCTX][k]; S17[e] = x / (1.0f + __expf(-x)); }
        __syncthreads();
        float* MOD = (float*)(ws + WS_MOD);
        for (int item = bid; item < 384; item += G) {
            const int i = item / 96, cb = item % 96;
            const float* wp = ap->in[I_ADAW] + ((size_t)i * 1024 + w * 128) * MODW + cb * 64 + lane;
            float acc[17];
#pragma unroll
            for (int b = 0; b < 17; ++b) acc[b] = 0.f;
            for (int k0 = 0; k0 < 128; k0 += 8) {
                float wv[8];
#pragma unroll
                for (int u = 0; u < 8; ++u) wv[u] = wp[(size_t)(k0 + u) * MODW];
#pragma unroll
                for (int u4 = 0; u4 < 2; ++u4)
#pragma unroll
                    for (int b = 0; b < 17; ++b) { const f32x4 s = *(const LAS f32x4*)(S17 + b * 1024 + w * 128 + k0 + 4 * u4);
                        acc[b] += (s[0] * wv[4 * u4] + s[1] * wv[4 * u4 + 1]) + (s[2] * wv[4 * u4 + 2] + s[3] * wv[4 * u4 + 3]); }
            }
#pragma unroll
            for (int b = 0; b < 17; ++b) RED[(w * 17 + b) * 64 + lane] = acc[b];
            __syncthreads();
            for (int o = tid; o < 17 * 64; o += 512) { const int b = o >> 6, ln = o & 63; float s = 0.f;
#pragma unroll
                for (int ww = 0; ww < 8; ++ww) s += RED[(ww * 17 + b) * 64 + ln];
                MOD[((size_t)i * 17 + b) * MODW + cb * 64 + ln] = s + ap->in[I_ADAB][i * MODW + cb * 64 + ln]; }
            __syncthreads();
        }
    }
    __syncthreads();
    LAS float* scr = (LAS float*)(lds + w * 16384);
    const int gw = bid * 8 + w, NGW = G * 8;
    constexpr int I_QKV = 16 * 96, I_SQ = 16 * 32, I_GU = 16 * 88, I_DN = 44 * 32, I_IN = 16 * 64, I_PL = 4 * 8;
    constexpr int NITEMS = 2 * I_QKV + 2 * I_SQ + 8 * I_GU + 4 * I_DN + I_IN + I_SQ + 4 * I_PL;
    for (int it = gw; it < NITEMS; it += NGW) {
        int r = it;
        if (r < 2 * I_QKV) { const int j = r / I_QKV; p0_transpose_item(ap->in[I_WQKV] + (size_t)j * D * 3072, D, 3072, (bf16_t*)(ws + WS_WQKV) + (size_t)j * 3072 * D, 1, 0, scr, r % I_QKV, lane); continue; } r -= 2 * I_QKV;
        if (r < 2 * I_SQ) { const int j = r / I_SQ; p0_transpose_item(ap->in[I_WO] + (size_t)j * D * D, D, D, (bf16_t*)(ws + WS_WO) + (size_t)j * D * D, 0, 0, scr, r % I_SQ, lane); continue; } r -= 2 * I_SQ;
        if (r < 8 * I_GU) { const int i = r / (2 * I_GU), gu = (r / I_GU) & 1; p0_transpose_item(ap->in[gu ? I_WU : I_WG] + (size_t)i * D * FF, D, FF, (bf16_t*)(ws + WS_WGU) + (size_t)i * 2 * FF * D, 2, gu * 128, scr, r % I_GU, lane); continue; } r -= 8 * I_GU;
        if (r < 4 * I_DN) { const int i = r / I_DN; p0_transpose_item(ap->in[I_WD] + (size_t)i * FF * D, FF, D, (bf16_t*)(ws + WS_WDN) + (size_t)i * D * FF, 0, 0, scr, r % I_DN, lane); continue; } r -= 4 * I_DN;
        if (r < I_IN) { p0_transpose_item(ap->in[I_GWIN], D, 2048, (bf16_t*)(ws + WS_WIN), 0, 0, scr, r, lane); continue; } r -= I_IN;
        if (r < I_SQ) { p0_transpose_item(ap->in[I_GWOUT], D, D, (bf16_t*)(ws + WS_WOUT), 0, 0, scr, r, lane); continue; } r -= I_SQ;
        { const int g = r / I_PL; p0_transpose_item(ap->in[I_PW] + (size_t)g * 256 * 256, 256, 256, (bf16_t*)(ws + WS_WPOOL), 0, g * 256, scr, r % I_PL, lane); }
    }
}

template <int NR>
__device__ __forceinline__ void norm_group(int m0, const float* xl, const float* xc, const float* gvec, const float* modl, int sh_off, int sc_off, bf16_t* Hout, int lane, float* cpl, float* cpc, const float* pend) {
    const bool lat = m0 < ML; const int bidx = lat ? (m0 >> 11) : NB;
    const float* xr = (lat ? xl : xc) + (size_t)m0 * D + 8 * lane;
    const float* mp = modl + (size_t)bidx * MODW;
    f32x4 v[NR][4]; float ss[NR];
#pragma unroll
    for (int r = 0; r < NR; ++r)
#pragma unroll
        for (int j = 0; j < 4; ++j) v[r][j] = __builtin_nontemporal_load((const f32x4*)(xr + (size_t)r * D + 512 * (j >> 1) + 4 * (j & 1)));
    if (pend && !lat) {
        const float* pp = pend + (size_t)(m0 - ML) * D + 8 * lane; float* xw = const_cast<float*>(xr);
#pragma unroll
        for (int q = 0; q < 4; ++q)
#pragma unroll
            for (int r = 0; r < NR; ++r)
#pragma unroll
                for (int j = 0; j < 4; ++j) v[r][j] += __builtin_nontemporal_load((const f32x4*)(pp + (size_t)q * MC * D + (size_t)r * D + 512 * (j >> 1) + 4 * (j & 1)));
#pragma unroll
        for (int r = 0; r < NR; ++r)
#pragma unroll
            for (int j = 0; j < 4; ++j) *(f32x4*)(xw + (size_t)r * D + 512 * (j >> 1) + 4 * (j & 1)) = v[r][j];
    }
    if (cpl) {
        float* cp = (lat ? cpl : cpc) + (size_t)m0 * D + 8 * lane;
#pragma unroll
        for (int r = 0; r < NR; ++r)
#pragma unroll
            for (int j = 0; j < 4; ++j) *(f32x4*)(cp + (size_t)r * D + 512 * (j >> 1) + 4 * (j & 1)) = v[r][j];
    }
#pragma unroll
    for (int r = 0; r < NR; ++r) { float s = 0.f;
#pragma unroll
        for (int j = 0; j < 4; ++j) s += (v[r][j][0] * v[r][j][0] + v[r][j][1] * v[r][j][1]) + (v[r][j][2] * v[r][j][2] + v[r][j][3] * v[r][j][3]);
        ss[r] = s; }
#pragma unroll
    for (int o = 1; o < 64; o <<= 1) {
#pragma unroll
        for (int r = 0; r < NR; ++r) ss[r] += __shfl_xor(ss[r], o);
    }
    float rstd[NR];
#pragma unroll
    for (int r = 0; r < NR; ++r) rstd[r] = __builtin_amdgcn_rsqf(ss[r] * (1.0f / D) + EPS);
#pragma unroll
    for (int h = 0; h < 2; ++h) { const int c = 8 * lane + 512 * h;
        const f32x4 ga = *(const f32x4*)(gvec + c), gb = *(const f32x4*)(gvec + c + 4), sca = *(const f32x4*)(mp + sc_off + c), scb = *(const f32x4*)(mp + sc_off + c + 4);
        const f32x4 sha = *(const f32x4*)(mp + sh_off + c), shb = *(const f32x4*)(mp + sh_off + c + 4);
        const f32x4 gma = ga * (sca + 1.0f), gmb = gb * (scb + 1.0f);
#pragma unroll
        for (int r = 0; r < NR; ++r) { const f32x4 oa = v[r][2 * h] * rstd[r] * gma + sha, ob = v[r][2 * h + 1] * rstd[r] * gmb + shb;
            u32x4 pk; pk.x = cvt_pk_bf16(oa[0], oa[1]); pk.y = cvt_pk_bf16(oa[2], oa[3]); pk.z = cvt_pk_bf16(ob[0], ob[1]); pk.w = cvt_pk_bf16(ob[2], ob[3]);
            *(u32x4*)(Hout + (size_t)(m0 + r) * D + c) = pk; }
    }
}
__device__ __forceinline__ void norm_phase(const float* xl, const float* xc, const float* gvec, const float* modl, int sh_off, int sc_off, bf16_t* Hout, int Mrows, int G, int bid, const int tid, float* cpl, float* cpc, const float* pend) {
    const int lane = tid & 63, w = tid >> 6;
    const int gw = bid * 8 + w, NGW = G * 8;
    const int Mlat = Mrows < ML ? Mrows : ML;
    for (int m0 = gw * 4; m0 < Mlat; m0 += NGW * 4) norm_group<4>(m0, xl, xc, gvec, modl, sh_off, sc_off, Hout, lane, cpl, cpc, nullptr);
    for (int m0 = ML + gw * 2; m0 < Mrows; m0 += NGW * 2) norm_group<2>(m0, xl, xc, gvec, modl, sh_off, sc_off, Hout, lane, cpl, cpc, pend);
}

constexpr int KP = 144, VP = 136;
constexpr int A_CK = 0, A_CV = A_CK + CTX * KP, A_LV = A_CV + CTX * VP, LV_SLOT = 64 * VP, A_RPB = A_LV + 9 * LV_SLOT, A_END = A_RPB + 15 * 64 * 4;
static_assert(A_END <= LDS_BYTES, "attention LDS map");

__device__ __forceinline__ s16x4 vtr(unsigned addr) { return __builtin_bit_cast(s16x4, __builtin_amdgcn_ds_read_tr16_b64_v4i16((LAS s16x4*)(uintptr_t)addr)); }

struct AttnState { f32x4 o[4]; float l; };
__device__ __forceinline__ void qk_chunk(float (&s)[8], bf16x8 k00, bf16x8 k01, bf16x8 k10, bf16x8 k11, bf16x8 q0, bf16x8 q1, float negm) {
    f32x4 z = (f32x4){negm, negm, negm, negm};
    f32x4 s0 = __builtin_amdgcn_mfma_f32_16x16x32_bf16(k00, q0, z, 0, 0, 0); s0 = __builtin_amdgcn_mfma_f32_16x16x32_bf16(k01, q1, s0, 0, 0, 0);
    f32x4 s1 = __builtin_amdgcn_mfma_f32_16x16x32_bf16(k10, q0, z, 0, 0, 0); s1 = __builtin_amdgcn_mfma_f32_16x16x32_bf16(k11, q1, s1, 0, 0, 0);
    s[0] = s0[0]; s[1] = s0[1]; s[2] = s0[2]; s[3] = s0[3]; s[4] = s1[0]; s[5] = s1[1]; s[6] = s1[2]; s[7] = s1[3];
}
__device__ __forceinline__ void qk_chunk_c(float (&s)[8], bf16x8 k00, bf16x8 k01, bf16x8 k10, bf16x8 k11, bf16x8 q0, bf16x8 q1, f32x4 c0, f32x4 c1) {
    f32x4 s0 = __builtin_amdgcn_mfma_f32_16x16x32_bf16(k00, q0, c0, 0, 0, 0); s0 = __builtin_amdgcn_mfma_f32_16x16x32_bf16(k01, q1, s0, 0, 0, 0);
    f32x4 s1 = __builtin_amdgcn_mfma_f32_16x16x32_bf16(k10, q0, c1, 0, 0, 0); s1 = __builtin_amdgcn_mfma_f32_16x16x32_bf16(k11, q1, s1, 0, 0, 0);
    s[0] = s0[0]; s[1] = s0[1]; s[2] = s0[2]; s[3] = s0[3]; s[4] = s1[0]; s[5] = s1[1]; s[6] = s1[2]; s[7] = s1[3];
}
__device__ __forceinline__ void softmax_pv(AttnState& st, const float (&s)[8], unsigned vaddr, float mq) {
    float p[8]; float ls = 0.f;
#pragma unroll
    for (int j = 0; j < 8; ++j) { p[j] = fast_exp2(s[j]); ls += p[j]; }
    st.l += ls;
    u32x4 pw; pw.x = cvt_pk_bf16(p[0], p[1]); pw.y = cvt_pk_bf16(p[2], p[3]); pw.z = cvt_pk_bf16(p[4], p[5]); pw.w = cvt_pk_bf16(p[6], p[7]);
    const bf16x8 pf = __builtin_bit_cast(bf16x8, pw);
#pragma unroll
    for (int db = 0; db < 4; ++db) {
        const s16x4 lo = vtr(vaddr + db * 32), hi = vtr(vaddr + db * 32 + 4 * VP);
        const bf16x8 vf = (bf16x8){lo[0], lo[1], lo[2], lo[3], hi[0], hi[1], hi[2], hi[3]};
        st.o[db] = __builtin_amdgcn_mfma_f32_16x16x32_bf16(vf, pf, st.o[db], 0, 0, 0);
    }
}

template <bool LOCAL>
__device__ __forceinline__ void attn_unit(LAS unsigned char* lds, const bf16_t* QKV, bf16_t* O, int qtok0, int h, int b, int r, int rs, int j, int lane, float kmax, float bmax) {
    const int fr = lane & 15, fq = lane >> 4;
    const unsigned lbase = (unsigned)(uintptr_t)lds;
    const bf16_t* qp = QKV + (size_t)(qtok0 + fr) * 3072 + h * 64 + 8 * fq;
    const u32x4 qw0 = *(const u32x4*)qp, qw1 = *(const u32x4*)(qp + 32);
    const bf16x8 q0 = __builtin_bit_cast(bf16x8, qw0), q1 = __builtin_bit_cast(bf16x8, qw1);
    const int kc0 = min(max(16 * j - 8, 0), 32);
    const int krow0 = 8 * (fr >> 2) + (fr & 3);
    bf16x8 kl[4][2][2];
    const bf16_t* kbase = QKV + (size_t)(b * SEQ + rs * 64 + kc0 + krow0) * 3072 + 1024 + h * 64 + 8 * fq;
#define LOADK(i) do { _Pragma("unroll") for (int t = 0; t < 2; ++t) { const bf16_t* kp = kbase + (size_t)((i) * 64 + 4 * t) * 3072; kl[(i) & 3][t][0] = *(const bf16x8*)kp; kl[(i) & 3][t][1] = *(const bf16x8*)(kp + 32); } } while (0)
    if (LOCAL) {
#pragma unroll
        for (int i = 0; i < 4; ++i) LOADK(i);
    }
    float qn = 0.f;
    { const unsigned qq[8] = {qw0.x, qw0.y, qw0.z, qw0.w, qw1.x, qw1.y, qw1.z, qw1.w};
#pragma unroll
      for (int e = 0; e < 8; ++e) { const float a = bf_lo(qq[e]), c = bf_hi(qq[e]); qn += a * a + c * c; } }
    qn += __shfl_xor(qn, 16); qn += __shfl_xor(qn, 32);
    const float mq = __builtin_sqrtf(qn) * kmax + (LOCAL ? bmax : 0.f);
    f32x4 bm[8][2];
    if (LOCAL) {
        const int qcol = 16 * j + fr, cstart = min(max(qcol - 8, 0), 48);
        const int kcol0 = kc0 + 8 * fq;
        const LAS float* rp = (const LAS float*)(lds + A_RPB) + (kcol0 - qcol + 15 + 16) + (rs - r + 7) * 64;
        float mk[8];
#pragma unroll
        for (int e = 0; e < 8; ++e) mk[e] = ((unsigned)(kcol0 + e - cstart) < 16u) ? -mq : -1e30f;
#pragma unroll
        for (int i = 0; i < 8; ++i)
#pragma unroll
            for (int e = 0; e < 8; ++e) bm[i][e >> 2][e & 3] = rp[i * 64 + e] + mk[e];
    }
    AttnState st;
#pragma unroll
    for (int db = 0; db < 4; ++db) st.o[db] = (f32x4){0.f, 0.f, 0.f, 0.f};
    st.l = 0.f;
    const unsigned vsub = (unsigned)((8 * fq + (fr >> 2)) * VP + 8 * (fr & 3));
#pragma unroll 2
    for (int c = 0; c < 8; ++c) {
        const LAS unsigned char* kb = lds + A_CK + (32 * c + krow0) * KP + 16 * fq;
        const bf16x8 k00 = *(const LAS bf16x8*)kb, k01 = *(const LAS bf16x8*)(kb + 64), k10 = *(const LAS bf16x8*)(kb + 4 * KP), k11 = *(const LAS bf16x8*)(kb + 4 * KP + 64);
        float s[8]; qk_chunk(s, k00, k01, k10, k11, q0, q1, -mq);
        softmax_pv(st, s, lbase + A_CV + 32 * c * VP + vsub, mq);
    }
    if (LOCAL) {
#pragma unroll
        for (int i = 0; i < 8; ++i) {
            float s[8]; qk_chunk_c(s, kl[i & 3][0][0], kl[i & 3][0][1], kl[i & 3][1][0], kl[i & 3][1][1], q0, q1, bm[i][0], bm[i][1]);
            if (i + 4 < 8) LOADK(i + 4);
            const int slot = (rs + i) % 9;
            softmax_pv(st, s, lbase + A_LV + slot * LV_SLOT + kc0 * VP + vsub, mq);
        }
    }
#undef LOADK
    float l = st.l; l += __shfl_xor(l, 16); l += __shfl_xor(l, 32);
    const float inv = fast_rcp(l);
    bf16_t* op = O + (size_t)(qtok0 + fr) * D + h * 64 + 4 * fq;
#pragma unroll
    for (int db = 0; db < 4; ++db) { const f32x4 o = st.o[db] * inv; u32x2 pk; pk.x = cvt_pk_bf16(o[0], o[1]); pk.y = cvt_pk_bf16(o[2], o[3]); *(u32x2*)(op + 16 * db) = pk; }
}

__device__ __forceinline__ void attn_phase(LAS unsigned char* lds, const bf16_t* QKV, bf16_t* O, const float* rpb, const float* kg, bool ctx_out, int G, int bid, const int tid) {
    const int lane = tid & 63, w = __builtin_amdgcn_readfirstlane(tid >> 6);
    float kmax = fabsf(kg[lane]);
#pragma unroll
    for (int o = 1; o < 64; o <<= 1) kmax = fmaxf(kmax, __shfl_xor(kmax, o));
    kmax *= 8.0f * 1.01f;
    for (int item = bid; item < NB * NH; item += G) {
        const int b = item >> 4, h = item & 15;
        const int ctxrow0 = ML + b * CTX;
        for (int c = tid; c < CTX * 8; c += 512) { const int key = c >> 3, ch = c & 7;
            const bf16_t* src = QKV + (size_t)(ctxrow0 + key) * 3072 + h * 64 + ch * 8;
            const u32x4 kv = *(const u32x4*)(src + 1024), vv = *(const u32x4*)(src + 2048);
            *(LAS u32x4*)(lds + A_CK + key * KP + ch * 16) = kv;
            *(LAS u32x2*)(lds + A_CV + key * VP + ch * 16) = (u32x2){vv.x, vv.y}; *(LAS u32x2*)(lds + A_CV + key * VP + ch * 16 + 8) = (u32x2){vv.z, vv.w}; }
        float bmax = 0.f;
        for (int c = lane; c < 15 * 31; c += 64) bmax = fmaxf(bmax, rpb[h * 15 * 31 + c] * LOG2E);
#pragma unroll
        for (int o = 1; o < 64; o <<= 1) bmax = fmaxf(bmax, __shfl_xor(bmax, o));
        for (int c = tid; c < 15 * 64; c += 512) { const int dr = c >> 6, x = (c & 63) - 16; ((LAS float*)(lds + A_RPB))[c] = (x >= 0 && x < 31) ? rpb[(h * 15 + dr) * 31 + x] * LOG2E : 0.f; }
        const int vkey = tid >> 3, vch = tid & 7;
        const bf16_t* vsrc = QKV + (size_t)(b * SEQ + vkey) * 3072 + 2048 + h * 64 + vch * 8;
        LAS unsigned char* vdst = lds + A_LV + vkey * VP + vch * 16;
        for (int row = 0; row < 8; ++row) { const u32x4 vv = *(const u32x4*)(vsrc + (size_t)row * 64 * 3072);
            LAS unsigned char* dst = vdst + row * LV_SLOT; *(LAS u32x2*)dst = (u32x2){vv.x, vv.y}; *(LAS u32x2*)(dst + 8) = (u32x2){vv.z, vv.w}; }
        int loaded_end = 8;
        for (int it = 0; it < 16; ++it) {
            const int r0 = 2 * it, rsA = min(max(r0 - 4, 0), 24), rsB = min(max(r0 - 3, 0), 24);
            const int next_end = it < 15 ? min(max(r0 - 1, 0), 24) + 8 : loaded_end;
            const int nnew = next_end - loaded_end;
            __syncthreads();
            u32x4 nv0 = (u32x4){0u, 0u, 0u, 0u}, nv1 = nv0;
            if (nnew > 0) nv0 = *(const u32x4*)(vsrc + (size_t)loaded_end * 64 * 3072);
            if (nnew > 1) nv1 = *(const u32x4*)(vsrc + (size_t)(loaded_end + 1) * 64 * 3072);
            { const int ri = w >> 2, j = w & 3, r = r0 + ri, rs = ri ? rsB : rsA;
              attn_unit<true>(lds, QKV, O, b * SEQ + r * 64 + 16 * j, h, b, r, rs, j, lane, kmax, bmax); }
            __syncthreads();
            if (nnew > 0) { LAS unsigned char* dst = vdst + (loaded_end % 9) * LV_SLOT; *(LAS u32x2*)dst = (u32x2){nv0.x, nv0.y}; *(LAS u32x2*)(dst + 8) = (u32x2){nv0.z, nv0.w}; }
            if (nnew > 1) { LAS unsigned char* dst = vdst + ((loaded_end + 1) % 9) * LV_SLOT; *(LAS u32x2*)dst = (u32x2){nv1.x, nv1.y}; *(LAS u32x2*)(dst + 8) = (u32x2){nv1.z, nv1.w}; }
            loaded_end = next_end;
        }
        if (ctx_out) {
            for (int uu = w; uu < 16; uu += 8) attn_unit<false>(lds, QKV, O, ctxrow0 + uu * 16, h, b, 0, 0, 0, lane, kmax, 0.f);
        }
        __syncthreads();
    }
}

#if defined(DBG_ATTN)
__device__ __forceinline__ float bfe(const bf16_t* p, int i) { return __uint_as_float(((unsigned)p[i]) << 16); }
__device__ __forceinline__ void attn_debug(LAS unsigned char* lds, const bf16_t* QKV, bf16_t* O, const float* rpb, bool ctx_out, int G, int bid, const int tid) {
    const int lane = tid & 63, w = tid >> 6;
    LAS float* P = (LAS float*)lds + w * 512;
    const long ntok = ctx_out ? MT : ML;
    for (long it = (long)bid * 8 + w; it < ntok * 16; it += (long)G * 8) {
        const int tok = (int)(it >> 4), h = (int)(it & 15);
        const bool isctx = tok >= ML;
        const int b = isctx ? ((tok - ML) >> 8) : (tok >> 11);
        const int t = tok & 2047, r = t >> 6, col = t & 63, j = col >> 4;
        const int kc0 = min(max(16 * j - 8, 0), 32), rs = min(max(r - 4, 0), 24), cstart = min(max(col - 8, 0), 48);
        const bf16_t* qp = QKV + (size_t)tok * 3072 + h * 64;
        float sc[8]; int kt[8];
#pragma unroll
        for (int k = 0; k < 8; ++k) {
            const int kidx = lane + 64 * (k & 3); bool ok = true; float bias = 0.f; int ktok;
            if (k < 4) { const int i = kidx >> 5, kk = kidx & 31, kcol = kc0 + kk; ktok = b * SEQ + (rs + i) * 64 + kcol; ok = !isctx && kcol >= cstart && kcol < cstart + 16;
                const int dr = rs + i - r + 7, dc = min(max(kcol - col + 15, 0), 30); bias = isctx ? 0.f : rpb[(h * 15 + dr) * 31 + dc] * LOG2E; if (isctx) ktok = ML + b * CTX; }
            else ktok = ML + b * CTX + kidx;
            kt[k] = ktok;
            const bf16_t* kp = QKV + (size_t)ktok * 3072 + 1024 + h * 64; float dot = 0.f;
            for (int d = 0; d < 64; ++d) dot += bfe(qp, d) * bfe(kp, d);
            sc[k] = ok ? dot + bias : -1e30f;
        }
        float m = -1e30f;
#pragma unroll
        for (int k = 0; k < 8; ++k) m = fmaxf(m, sc[k]);
        for (int o = 1; o < 64; o <<= 1) m = fmaxf(m, __shfl_xor(m, o));
        float l = 0.f;
#pragma unroll
        for (int k = 0; k < 8; ++k) { const float p = exp2f(sc[k] - m); l += p; P[k * 64 + lane] = p; }
        l = wave_sum(l);
        float acc = 0.f;
#pragma unroll
        for (int k = 0; k < 8; ++k) for (int ln = 0; ln < 64; ++ln) { const int ktok = __shfl(kt[k], ln); acc += P[k * 64 + ln] * bfe(QKV + (size_t)ktok * 3072 + 2048 + h * 64, lane); }
        O[(size_t)tok * D + h * 64 + lane] = (bf16_t)f2bf(acc / l);
    }
}
#endif
__device__ __forceinline__ void ld8(float (&o)[8], const bf16_t* p);
constexpr int VNP = 264;
__device__ __forceinline__ void spatial_phase(LAS unsigned char* lds, const bf16_t* Z, const float* stats, const float* ln_g, const float* ln_b, const float* w_s, const float* b_s, bf16_t* UM, int G, int bid, const int tid) {
    const int lane = tid & 63, w = __builtin_amdgcn_readfirstlane(tid >> 6), fr = lane & 15, fq = lane >> 4;
    LAS f32x2* ST = (LAS f32x2*)(lds + 128 * VNP);
    const unsigned lbase = (unsigned)(uintptr_t)lds;
    const int p = 16 * w + fr;
    constexpr int NITEM = (MT / 128) * 8;
    f32x4 wa[4][2]; u32x2 ur[8]; float bs = 0.f; u32x4 rawv[4]; f32x4 sp[8];
#define SP_LOAD(it) do { const int n_ = (it) >> 3, g_ = (it) & 7, m0_ = n_ * 128; \
        _Pragma("unroll") for (int ks = 0; ks < 4; ++ks) { const float* wp = w_s + ((size_t)(g_ * 128 + p)) * 128 + 32 * ks + 8 * fq; wa[ks][0] = *(const f32x4*)wp; wa[ks][1] = *(const f32x4*)(wp + 4); } \
        _Pragma("unroll") for (int db = 0; db < 8; ++db) ur[db] = *(const u32x2*)(Z + (size_t)(m0_ + p) * 2048 + g_ * 128 + 16 * db + 4 * fq); \
        bs = b_s[g_ * 128 + p]; \
        _Pragma("unroll") for (int i4 = 0; i4 < 4; ++i4) { const int c = tid + 512 * i4; rawv[i4] = *(const u32x4*)(Z + (size_t)(m0_ + (c >> 4)) * 2048 + 1024 + g_ * 128 + (c & 15) * 8); } \
        if (tid < 128) { const float* spp = stats + (size_t)(m0_ + tid) * 32; _Pragma("unroll") for (int k = 0; k < 8; ++k) sp[k] = *(const f32x4*)(spp + 4 * k); } } while (0)
    if (bid < NITEM) SP_LOAD(bid);
    for (int item = bid; item < NITEM; item += G) {
        const int n = item >> 3, g = item & 7, m0 = n * 128;
        if (tid < 128) { float s = 0.f, ss = 0.f;
#pragma unroll
            for (int k = 0; k < 8; ++k) { s += sp[k][0] + sp[k][2]; ss += sp[k][1] + sp[k][3]; }
            const float mean = s * (1.0f / 1024.0f), var = ss * (1.0f / 1024.0f) - mean * mean;
            ST[tid] = (f32x2){mean, __builtin_amdgcn_rsqf(fmaxf(var, 0.f) + EPS)}; }
        __syncthreads();
#pragma unroll
        for (int i4 = 0; i4 < 4; ++i4) { const int c = tid + 512 * i4; const int q = c >> 4, ch = c & 15;
            const u32x4 raw = rawv[i4];
            const f32x2 st = ST[q];
            const float* gp = ln_g + g * 128 + ch * 8; const float* bp = ln_b + g * 128 + ch * 8;
            const f32x4 g0 = *(const f32x4*)gp, g1 = *(const f32x4*)(gp + 4), b0 = *(const f32x4*)bp, b1 = *(const f32x4*)(bp + 4);
            float o[8];
            o[0] = (bf_lo(raw.x) - st.x) * st.y * g0[0] + b0[0]; o[1] = (bf_hi(raw.x) - st.x) * st.y * g0[1] + b0[1];
            o[2] = (bf_lo(raw.y) - st.x) * st.y * g0[2] + b0[2]; o[3] = (bf_hi(raw.y) - st.x) * st.y * g0[3] + b0[3];
            o[4] = (bf_lo(raw.z) - st.x) * st.y * g1[0] + b1[0]; o[5] = (bf_hi(raw.z) - st.x) * st.y * g1[1] + b1[1];
            o[6] = (bf_lo(raw.w) - st.x) * st.y * g1[2] + b1[2]; o[7] = (bf_hi(raw.w) - st.x) * st.y * g1[3] + b1[3];
            LAS unsigned char* dst = lds + q * VNP + ch * 16;
            *(LAS u32x2*)dst = (u32x2){cvt_pk_bf16(o[0], o[1]), cvt_pk_bf16(o[2], o[3])}; *(LAS u32x2*)(dst + 8) = (u32x2){cvt_pk_bf16(o[4], o[5]), cvt_pk_bf16(o[6], o[7])}; }
        bf16x8 wf[4];
#pragma unroll
        for (int ks = 0; ks < 4; ++ks) { u32x4 pw; pw.x = cvt_pk_bf16(wa[ks][0][0], wa[ks][0][1]); pw.y = cvt_pk_bf16(wa[ks][0][2], wa[ks][0][3]); pw.z = cvt_pk_bf16(wa[ks][1][0], wa[ks][1][1]); pw.w = cvt_pk_bf16(wa[ks][1][2], wa[ks][1][3]); wf[ks] = __builtin_bit_cast(bf16x8, pw); }
        u32x2 urc[8];
#pragma unroll
        for (int db = 0; db < 8; ++db) urc[db] = ur[db];
        const float bsc = bs;
        __syncthreads();
        if (item + G < NITEM) SP_LOAD(item + G);
        const unsigned vsub = lbase + (unsigned)((8 * fq + (fr >> 2)) * VNP + 8 * (fr & 3));
#pragma unroll
        for (int db = 0; db < 8; ++db) {
            f32x4 acc = (f32x4){0.f, 0.f, 0.f, 0.f};
#pragma unroll
            for (int ks = 0; ks < 4; ++ks) {
                const s16x4 lo = vtr(vsub + 32 * ks * VNP + db * 32), hi = vtr(vsub + (32 * ks + 4) * VNP + db * 32);
                const bf16x8 vf = (bf16x8){lo[0], lo[1], lo[2], lo[3], hi[0], hi[1], hi[2], hi[3]};
                acc = __builtin_amdgcn_mfma_f32_16x16x32_bf16(vf, wf[ks], acc, 0, 0, 0);
            }
            u32x2 pk; pk.x = cvt_pk_bf16(bf_lo(urc[db].x) * (acc[0] + bsc), bf_hi(urc[db].x) * (acc[1] + bsc)); pk.y = cvt_pk_bf16(bf_lo(urc[db].y) * (acc[2] + bsc), bf_hi(urc[db].y) * (acc[3] + bsc));
            *(u32x2*)(UM + (size_t)(m0 + p) * D + g * 128 + 16 * db + 4 * fq) = pk;
        }
        __syncthreads();
    }
#undef SP_LOAD
}

__device__ __forceinline__ void ld8(float (&o)[8], const bf16_t* p) { const u32x4 r = *(const u32x4*)p; o[0] = bf_lo(r.x); o[1] = bf_hi(r.x); o[2] = bf_lo(r.y); o[3] = bf_hi(r.y); o[4] = bf_lo(r.z); o[5] = bf_hi(r.z); o[6] = bf_lo(r.w); o[7] = bf_hi(r.w); }
__device__ __forceinline__ void ld8l(float (&o)[8], const LAS unsigned char* p) { const u32x4 r = *(const LAS u32x4*)p; o[0] = bf_lo(r.x); o[1] = bf_hi(r.x); o[2] = bf_lo(r.y); o[3] = bf_hi(r.y); o[4] = bf_lo(r.z); o[5] = bf_hi(r.z); o[6] = bf_lo(r.w); o[7] = bf_hi(r.w); }
__device__ __forceinline__ void pooldiff_phase(LAS unsigned char* lds, const bf16_t* H, bf16_t* PD, int G, int bid, const int tid) {
    for (int item = bid; item < MT / 32; item += G) {
        const int m0 = item * 32;
        int seq0, L;
        if (m0 < ML) { seq0 = (m0 >> 11) << 11; L = SEQ; } else { seq0 = ML + (((m0 - ML) >> 8) << 8); L = CTX; }
        const int t0 = m0 - seq0, lo_t = max(t0 - 8, 0), hi_t = min(t0 + 40, L), ncell = (hi_t - lo_t) * 128;
        u32x4 tmp[12];
#pragma unroll
        for (int i = 0; i < 12; ++i) { const int c = tid + 512 * i; if (c < ncell) tmp[i] = *(const u32x4*)(H + (size_t)(seq0 + lo_t + (c >> 7)) * D + (c & 127) * 8); }
#pragma unroll
        for (int i = 0; i < 12; ++i) { const int c = tid + 512 * i; if (c < ncell) *(LAS u32x4*)(lds + (lo_t + (c >> 7) - (t0 - 8)) * 2048 + (c & 127) * 16) = tmp[i]; }
        __syncthreads();
        const int ch = tid & 127, tb = t0 + (tid >> 7) * 8, g = ch >> 5, wdw = 2 << g, half = wdw >> 1;
        const LAS unsigned char* lb = lds + ch * 16; const int rb = t0 - 8;
        bf16_t* ob = PD + (size_t)seq0 * D + ch * 8;
        float acc[8];
#pragma unroll
        for (int e = 0; e < 8; ++e) acc[e] = 0.f;
        int lo = max(tb - half, 0), hi = min(tb - half + wdw, L);
        for (int t = lo; t < hi; ++t) { float v[8]; ld8l(v, lb + (t - rb) * 2048);
#pragma unroll
            for (int e = 0; e < 8; ++e) acc[e] += v[e]; }
#pragma unroll
        for (int k = 0; k < 8; ++k) {
            const int t = tb + k; float own[8]; ld8l(own, lb + (t - rb) * 2048);
            const float ic = 1.0f / (float)(hi - lo);
            u32x4 w; w.x = cvt_pk_bf16(acc[0] * ic - own[0], acc[1] * ic - own[1]); w.y = cvt_pk_bf16(acc[2] * ic - own[2], acc[3] * ic - own[3]);
            w.z = cvt_pk_bf16(acc[4] * ic - own[4], acc[5] * ic - own[5]); w.w = cvt_pk_bf16(acc[6] * ic - own[6], acc[7] * ic - own[7]);
            *(u32x4*)(ob + (size_t)t * D) = w;
            const int nlo = max(t + 1 - half, 0), nhi = min(t + 1 - half + wdw, L);
            if (nhi > hi) { float v[8]; ld8l(v, lb + (hi - rb) * 2048);
#pragma unroll
                for (int e = 0; e < 8; ++e) acc[e] += v[e]; }
            if (nlo > lo) { float v[8]; ld8l(v, lb + (lo - rb) * 2048);
#pragma unroll
                for (int e = 0; e < 8; ++e) acc[e] -= v[e]; }
            lo = nlo; hi = nhi;
        }
        __syncthreads();
    }
}

constexpr size_t WS_BAR = 0x1F0000;
constexpr int MISC_OFF = LDS_BYTES - 64;
#define XB_TMO      128
#define XB_XCNT(j)  (256  + 64 * (j))
#define XB_XSUB(j)  (1280 + 64 * (j))
#define XB_XGEN(j)  (2304 + 64 * (j))
#define XB_TOP      3328
#define XB_TOPGEN   3392
#define XCD_BAR_WORDS 3456
#define XB_SPIN_CAP (1u << 18)

__device__ __forceinline__ unsigned xb_ld(unsigned* p)              { return __hip_atomic_load(p, __ATOMIC_RELAXED, __HIP_MEMORY_SCOPE_AGENT); }
__device__ __forceinline__ unsigned xb_add(unsigned* p, unsigned v) { return __hip_atomic_fetch_add(p, v, __ATOMIC_RELAXED, __HIP_MEMORY_SCOPE_AGENT); }
__device__ __forceinline__ unsigned xb_xcc_id() { return (unsigned)__builtin_amdgcn_s_getreg((3 << 11) | 20) & 0xFu; }
#define XB_SPIN(cond, bar) do { unsigned _sp = 0; while (cond) { __builtin_amdgcn_s_sleep(1); \
    if ((++_sp & 255u) == 0u) { if (xb_ld(&(bar)[XB_TMO])) break; if (_sp > XB_SPIN_CAP) { atomicAdd(&(bar)[XB_TMO], 1u); break; } } } } while (0)

struct XcdBarrier {
    unsigned* bar; unsigned x;
    volatile LAS unsigned* st;
};

__device__ __forceinline__ XcdBarrier xcd_barrier_post(unsigned* bar, volatile LAS unsigned* st) {
    XcdBarrier b; b.bar = bar; b.x = xb_xcc_id(); b.st = st;
    if (threadIdx.x == 0) (void)xb_add(&bar[XB_XCNT(b.x)], 1u);
    return b;
}
__device__ __forceinline__ void xcd_barrier_complete(unsigned* bar, unsigned x, unsigned& nloc, unsigned& nx) {
    const unsigned G = gridDim.x * gridDim.y * gridDim.z;
    unsigned sum, cnt, mine, sp = 0u;
    for (;;) {
        sum = 0u; cnt = 0u; mine = 0u;
#pragma unroll
        for (unsigned j = 0; j < 16; ++j) { const unsigned c = xb_ld(&bar[XB_XCNT(j)]); sum += c; cnt += (c > 0u) ? 1u : 0u; mine = (j == x) ? c : mine; }
        if (sum == G) break;
        __builtin_amdgcn_s_sleep(1);
        if ((++sp & 255u) == 0u) { if (xb_ld(&bar[XB_TMO])) break; if (sp > XB_SPIN_CAP) { atomicAdd(&bar[XB_TMO], 1u); break; } }
    }
    nloc = mine > 0u ? mine : 1u; nx = cnt > 0u ? cnt : 1u;
}

__device__ __forceinline__ void xcd_barrier(const XcdBarrier& b) {
    asm volatile("s_waitcnt vmcnt(0)" ::: "memory");
    __syncthreads();
    if (threadIdx.x == 0) {
        unsigned* bar = b.bar;
        __builtin_amdgcn_s_waitcnt(0);
        unsigned nloc = b.st[0], nx = b.st[1];
        if (nloc == 0u) { xcd_barrier_complete(bar, b.x, nloc, nx); b.st[0] = nloc; b.st[1] = nx; }
        const unsigned old = xb_add(&bar[XB_XSUB(b.x)], 1u);
        const unsigned gen = old / nloc;
        if (old + 1u == (gen + 1u) * nloc) {
            __builtin_amdgcn_fence(__ATOMIC_RELEASE, "agent");
            asm volatile("s_waitcnt vmcnt(0)" ::: "memory");
            const unsigned og = xb_add(&bar[XB_TOP], 1u);
            const unsigned tg = og / nx;
            if (og + 1u == (tg + 1u) * nx) xb_add(&bar[XB_TOPGEN], 1u);
            else XB_SPIN(xb_ld(&bar[XB_TOPGEN]) == tg, bar);
            __builtin_amdgcn_fence(__ATOMIC_ACQUIRE, "agent");
            xb_add(&bar[XB_XGEN(b.x)], 1u);
            asm volatile("s_waitcnt vmcnt(0)" ::: "memory");
        } else {
            XB_SPIN(xb_ld(&bar[XB_XGEN(b.x)]) == gen, bar);
            __builtin_amdgcn_fence(__ATOMIC_ACQUIRE, "agent");
            asm volatile("s_waitcnt vmcnt(0)" ::: "memory");
        }
    }
    __syncthreads();
}


constexpr int NPHASES = 28;
enum { OP_P0 = 0, OP_NORM1, OP_QKV, OP_ATTN, OP_WO, OP_WIN, OP_SPATIAL, OP_WOUT, OP_POOLDIFF, OP_POOLGEMM, OP_NORM2, OP_GU, OP_DOWN };
__constant__ unsigned char PH_OP[NPHASES] = { OP_P0,
    OP_NORM1, OP_QKV, OP_ATTN, OP_WO, OP_NORM2, OP_GU, OP_DOWN,
    OP_NORM1, OP_WIN, OP_SPATIAL, OP_WOUT, OP_NORM2, OP_GU, OP_DOWN,
    OP_NORM1, OP_POOLDIFF, OP_POOLGEMM, OP_NORM2, OP_GU, OP_DOWN,
    OP_NORM1, OP_QKV, OP_ATTN, OP_WO, OP_NORM2, OP_GU, OP_DOWN };
__constant__ unsigned char PH_LAYER[NPHASES] = { 0, 0, 0, 0, 0, 0, 0, 0, 1, 1, 1, 1, 1, 1, 1, 2, 2, 2, 2, 2, 2, 3, 3, 3, 3, 3, 3, 3 };
#ifndef PH_MASK
#define PH_MASK 0xffff
#endif
#define OPON(bit) ((PH_MASK >> (bit)) & 1)

__global__ void __launch_bounds__(512, 2) mk_fwd(Args a) {
    extern __shared__ __attribute__((aligned(16))) unsigned char lds_raw[];
    LAS unsigned char* lds = (LAS unsigned char*)lds_raw;
#if !MK_MULTI
    cg::grid_group grid = cg::this_grid();
    volatile LAS unsigned* MISC = (volatile LAS unsigned*)(lds + MISC_OFF);
    if (threadIdx.x < 16) MISC[threadIdx.x] = 0u;
    __syncthreads();
    (void)xcd_barrier_post((unsigned*)(a.ws + WS_BAR), MISC);
#endif
#ifndef DUP_OP
#define DUP_OP 99
#endif
    for (int ph = a.ph_lo, rep = 0; ph < a.ph_hi; ++ph) {
        int tid = threadIdx.x, bid = blockIdx.x, G = gridDim.x; asm volatile("" : "+v"(tid)); asm volatile("" : "+s"(bid), "+s"(G));
        ArgsP ap = (ArgsP)__builtin_amdgcn_kernarg_segment_ptr(); asm volatile("" : "+s"(ap));
        unsigned char* ws = ap->ws;
        const int op = PH_OP[ph], layer = PH_LAYER[ph], j = layer / 3; const bool last = layer == 3;
        float* MOD = (float*)(ws + WS_MOD); float* STATS = (float*)(ws + WS_STATS);
        float* XL = ap->out; float* XC = (float*)(ws + WS_XCTX) - (size_t)ML * D;
        bf16_t* Hb = (bf16_t*)(ws + WS_H); bf16_t* Ob = (bf16_t*)(ws + WS_O); bf16_t* BIG = (bf16_t*)(ws + WS_BIG);
        const float* modl = MOD + (size_t)layer * 17 * MODW;
        const float* xin_l = layer == 0 ? ap->in[I_X] : XL; const float* xin_c = layer == 0 ? ap->in[I_CTX] - (size_t)ML * D : XC;
        const int Mrows = last ? ML : MT;
        pg8::StaticOrder S;
        if (op == OP_P0) { if (OPON(0)) p0_prologue(ap, lds, G, bid, tid); }
        else if (op == OP_NORM1 || op == OP_NORM2) {
            if (OPON(1)) { const bool n1 = op == OP_NORM1;
                norm_phase(n1 ? xin_l : XL, n1 ? xin_c : XC, ap->in[n1 ? I_N1G : I_N2G] + layer * D, modl, n1 ? 0 : 3 * D, n1 ? D : 4 * D, Hb, n1 ? MT : Mrows, G, bid, tid, (n1 && layer == 0) ? XL : nullptr, XC,
                           n1 ? (layer > 0 ? (const float*)Ob : nullptr) : ((layer < 2) ? (const float*)BIG : nullptr)); }
        } else if (op == OP_QKV) {
            if (OPON(2)) { pg8::Gemm g{Hb, (const bf16_t*)(ws + WS_WQKV) + (size_t)j * 3072 * D, MT, 3072, D, D, 0}; S.init(MT, 3072, D, G, bid);
                EpiQKV E{BIG, ap->in[I_QN] + j * HD, ap->in[I_KN] + j * HD}; pg8::gemm_phase<EpiQKV>(lds, g, S, E, tid); }
        } else if (op == OP_ATTN) {
#if defined(DBG_ATTN)
            if (OPON(3)) attn_debug(lds, BIG, Ob, ap->in[I_RPB] + (size_t)j * NH * 15 * 31, !last, G, bid, tid);
#else
            if (OPON(3)) attn_phase(lds, BIG, Ob, ap->in[I_RPB] + (size_t)j * NH * 15 * 31, ap->in[I_KN] + j * HD, !last, G, bid, tid);
#endif
        } else if (op == OP_WIN) {
            if (OPON(5)) { pg8::Gemm g{Hb, (const bf16_t*)(ws + WS_WIN), MT, 2048, D, D, 0}; S.init(MT, 2048, D, G, bid);
                EpiGelu E{BIG, ap->in[I_GBIN], STATS}; pg8::gemm_phase<EpiGelu>(lds, g, S, E, tid); }
        } else if (op == OP_SPATIAL) {
            if (OPON(6)) spatial_phase(lds, BIG, STATS, ap->in[I_GLNG], ap->in[I_GLNB], ap->in[I_GWS], ap->in[I_GBS], Ob, G, bid, tid);
        } else if (op == OP_POOLDIFF) {
            if (OPON(7)) pooldiff_phase(lds, Hb, Ob, G, bid, tid);
        } else if (op == OP_GU) {
            if (OPON(8)) { pg8::Gemm g{Hb, (const bf16_t*)(ws + WS_WGU) + (size_t)layer * 2 * FF * D, Mrows, 2 * FF, D, D, 0}; S.init(Mrows, 2 * FF, D, G, bid);
                EpiSwiGLU E{BIG}; pg8::gemm_phase<EpiSwiGLU>(lds, g, S, E, tid); }
        } else {
            if (OPON(4)) {
                pg8::Gemm g{Ob, nullptr, Mrows, D, D, D, 0};
                EpiResid E{XL, XC, XL, XC, modl + 2 * D, nullptr, (float*)BIG};
                if (op == OP_WO) g.Bt = (const bf16_t*)(ws + WS_WO) + (size_t)j * D * D;
                else if (op == OP_WOUT) g.Bt = (const bf16_t*)(ws + WS_WOUT);
                else if (op == OP_POOLGEMM) { g.Bt = (const bf16_t*)(ws + WS_WPOOL); g.K = 256; g.a_pn_off = 512; E.cscale = ap->in[I_PS]; }
                else { g.A = BIG; g.Bt = (const bf16_t*)(ws + WS_WDN) + (size_t)layer * D * FF; g.K = FF; g.lda = FF; E.mod = modl + 5 * D; E.part = (float*)Ob; }
                if (op != OP_POOLGEMM && Mrows == MT) S.init(ML, D, g.K, G, bid, MC);
                else S.init(Mrows, D, g.K, G, bid);
                pg8::gemm_phase<EpiResid>(lds, g, S, E, tid);
            }
        }
#if !MK_MULTI
        if (ph + 1 < a.ph_hi) { if (a.ph_hi > 1000000) grid.sync(); else { XcdBarrier xb; xb.bar = (unsigned*)(ap->ws + WS_BAR); xb.x = xb_xcc_id(); xb.st = (volatile LAS unsigned*)(lds + MISC_OFF); xcd_barrier(xb); } }
#endif
        if (PH_OP[ph] == DUP_OP && rep == 0) { rep = 1; --ph; } else rep = 0;
    }
}


#if defined(DBG_CHECK)
constexpr size_t WS_FLAGS = WS_END, WS_EXP = WS_END + 4096;
constexpr int NSAMP = 4096;
__device__ __forceinline__ float rbf(float x) { return __uint_as_float(f2bf(x) << 16); }
__device__ __forceinline__ float bfv(const bf16_t* p, size_t i) { return __uint_as_float(((unsigned)p[i]) << 16); }
__device__ __forceinline__ unsigned hash32(unsigned x) { x ^= x >> 16; x *= 0x7feb352dU; x ^= x >> 15; x *= 0x846ca68bU; x ^= x >> 16; return x; }
__global__ void chk_kernel(Args a, int ph, int mode) {
    const int s = blockIdx.x * blockDim.x + threadIdx.x; if (s >= NSAMP) return;
    unsigned char* ws = a.ws; unsigned* FLAGS = (unsigned*)(ws + WS_FLAGS); float* EXP = (float*)(ws + WS_EXP);
    const int op = PH_OP[ph], layer = PH_LAYER[ph], j = layer / 3; const bool last = layer == 3;
    float* MOD = (float*)(ws + WS_MOD);
    float* XL = a.out; float* XC = (float*)(ws + WS_XCTX) - (size_t)ML * D;
    bf16_t* Hb = (bf16_t*)(ws + WS_H); bf16_t* Ob = (bf16_t*)(ws + WS_O); bf16_t* BIG = (bf16_t*)(ws + WS_BIG);
    const float* modl = MOD + (size_t)layer * 17 * MODW;
    const float* xin_l = layer == 0 ? a.in[I_X] : XL; const float* xin_c = layer == 0 ? a.in[I_CTX] - (size_t)ML * D : XC;
    const int Mrows = last ? ML : MT;
    const unsigned h1 = hash32(s * 2654435761u + ph * 97u + 1u), h2 = hash32(h1 + 0x9e3779b9u);
    bool bad = false;
#define cmp(got, want) do { const float w_ = (want); const float e_ = fabsf((got) - w_); if (!(e_ <= 0.02f + 0.02f * fabsf(w_))) bad = true; } while (0)
    if (op == OP_NORM1 || op == OP_NORM2) { if (mode == 0) return;
        const bool n1 = op == OP_NORM1; const int rows = n1 ? MT : Mrows; const int m = h1 % rows, c = h2 % D;
        const float* xr = (m < ML ? (n1 ? xin_l : XL) : (n1 ? xin_c : XC)) + (size_t)m * D; float ss = 0.f; for (int k = 0; k < D; ++k) ss += xr[k] * xr[k];
        const float* mp = modl + (size_t)(m < ML ? (m >> 11) : NB) * MODW; const float g = a.in[n1 ? I_N1G : I_N2G][layer * D + c];
        const float want = xr[c] * rsqrtf(ss / D + EPS) * g * (1.f + mp[(n1 ? D : 4 * D) + c]) + mp[(n1 ? 0 : 3 * D) + c];
        cmp(bfv(Hb, (size_t)m * D + c), want);
    } else if (op == OP_QKV) { if (mode == 0) return;
        const int m = h1 % MT, hd48 = h2 % 48, kind = hd48 / 16; const float* W = a.in[I_WQKV] + (size_t)j * D * 3072; float ss = 0.f;
        for (int d = 0; d < 64; ++d) { float acc = 0.f; for (int k = 0; k < D; ++k) acc += bfv(Hb, (size_t)m * D + k) * rbf(W[(size_t)k * 3072 + hd48 * 64 + d]); ss += acc * acc; }
        const float rs = rsqrtf(ss / 64.f + EPS);
        for (int d = 0; d < 64; ++d) { float acc = 0.f; for (int k = 0; k < D; ++k) acc += bfv(Hb, (size_t)m * D + k) * rbf(W[(size_t)k * 3072 + hd48 * 64 + d]);
            float want = acc; if (kind == 0) want = acc * rs * a.in[I_QN][j * 64 + d] * QSCALE; else if (kind == 1) want = acc * rs * a.in[I_KN][j * 64 + d];
            cmp(bfv(BIG, (size_t)m * 3072 + hd48 * 64 + d), want); }
    } else if (op == OP_WIN) { if (mode == 0) return;
        const int m = h1 % MT, c = h2 % 2048; float acc = 0.f; for (int k = 0; k < D; ++k) acc += bfv(Hb, (size_t)m * D + k) * rbf(a.in[I_GWIN][(size_t)k * 2048 + c]);
        const float x = acc + a.in[I_GBIN][c]; const float want = 0.5f * x * (1.f + tanhf(0.7978845608f * (x + 0.044715f * x * x * x)));
        cmp(bfv(BIG, (size_t)m * 2048 + c), want);
    } else if (op == OP_GU) { if (mode == 0) return;
        const int m = h1 % Mrows, c = h2 % FF; float ag = 0.f, au = 0.f; const float* Wg = a.in[I_WG] + (size_t)layer * D * FF; const float* Wu = a.in[I_WU] + (size_t)layer * D * FF;
        for (int k = 0; k < D; ++k) { const float hv = bfv(Hb, (size_t)m * D + k); ag += hv * rbf(Wg[(size_t)k * FF + c]); au += hv * rbf(Wu[(size_t)k * FF + c]); }
        cmp(bfv(BIG, (size_t)m * FF + c), ag / (1.f + expf(-ag)) * au);
    } else if (op == OP_WO || op == OP_WOUT || op == OP_POOLGEMM || op == OP_DOWN) {
        const int m = h1 % Mrows, c = h2 % D; const bool lat = m < ML;
        if (mode == 0) {
            float acc = 0.f;
            if (op == OP_WO) { const float* W = a.in[I_WO] + (size_t)j * D * D; for (int k = 0; k < D; ++k) acc += bfv(Ob, (size_t)m * D + k) * rbf(W[(size_t)k * D + c]); }
            else if (op == OP_WOUT) { for (int k = 0; k < D; ++k) acc += bfv(Ob, (size_t)m * D + k) * rbf(a.in[I_GWOUT][(size_t)k * D + c]); }
            else if (op == OP_POOLGEMM) { const int g = c >> 8; for (int k = 0; k < 256; ++k) acc += bfv(Ob, (size_t)m * D + g * 256 + k) * rbf(a.in[I_PW][((size_t)g * 256 + k) * 256 + (c & 255)]); acc *= a.in[I_PS][c]; }
            else { const float* W = a.in[I_WD] + (size_t)layer * FF * D; for (int k = 0; k < FF; ++k) acc += bfv(BIG, (size_t)m * FF + k) * rbf(W[(size_t)k * D + c]); }
            const float gate = modl[(size_t)(lat ? (m >> 11) : NB) * MODW + (op == OP_DOWN ? 5 * D : 2 * D) + c];
            const float base = (lat ? XL : XC)[(size_t)m * D + c];
            EXP[s] = base + gate * acc; if (ph == 7) EXP[NSAMP + s] = (lat ? a.in[I_X][(size_t)m * D + c] : a.in[I_CTX][(size_t)(m - ML) * D + c]) + gate * acc;
        } else { cmp((lat ? XL : XC)[(size_t)m * D + c], EXP[s]); if (ph == 7) { if (fabsf((lat ? XL : XC)[(size_t)m * D + c] - EXP[NSAMP + s]) < 0.01f) atomicAdd(FLAGS + 102, 1u); atomicAdd((float*)(FLAGS + 100), fabsf((lat ? XL : XC)[(size_t)m * D + c] - EXP[s])); if (!lat) atomicAdd((float*)(FLAGS + 101), fabsf(XC[(size_t)m * D + c] - EXP[s])); } }
    } else if (op == OP_SPATIAL) { if (mode == 0) return;
        const int m = h1 % MT, c = h2 % D, g = c >> 7, m0 = m & ~127, p = m & 127; float acc = 0.f;
        for (int q = 0; q < 128; ++q) { const bf16_t* zr = BIG + (size_t)(m0 + q) * 2048 + 1024; float su = 0.f, sq = 0.f; for (int k = 0; k < 1024; ++k) { const float x = bfv(zr, k); su += x; sq += x * x; }
            const float mean = su / 1024.f, var = sq / 1024.f - mean * mean; const float vn = (bfv(zr, c) - mean) * rsqrtf(var + EPS) * a.in[I_GLNG][c] + a.in[I_GLNB][c];
            acc += a.in[I_GWS][((size_t)g * 128 + p) * 128 + q] * vn; }
        cmp(bfv(Ob, (size_t)m * D + c), bfv(BIG, (size_t)m * 2048 + c) * (acc + a.in[I_GBS][g * 128 + p]));
    } else if (op == OP_POOLDIFF) { if (mode == 0) return;
        const int m = h1 % MT, c = h2 % D, g = c >> 8, w = 2 << g; int seq0, L; if (m < ML) { seq0 = m & ~2047; L = SEQ; } else { seq0 = ML + ((m - ML) & ~255); L = CTX; }
        const int t = m - seq0, lo = max(t - w / 2, 0), hi = min(t - w / 2 + w, L); float su = 0.f; for (int tt = lo; tt < hi; ++tt) su += bfv(Hb, (size_t)(seq0 + tt) * D + c);
        cmp(bfv(Ob, (size_t)m * D + c), su / (hi - lo) - bfv(Hb, (size_t)m * D + c));
    } else if (op == OP_P0) { if (mode == 0) return;
        const int i = s & 3, c = h1 % D, k = h2 % FF;
        const bf16_t* WT = (const bf16_t*)(ws + WS_WDN) + (size_t)i * D * FF; const float* W = a.in[I_WD] + (size_t)i * FF * D;
        cmp(bfv(WT, (size_t)c * FF + k), rbf(W[(size_t)k * D + c]));
    } else return;
    if (bad) atomicAdd(FLAGS + ph, 1u);
}
__global__ void chk_report(Args a) {
    unsigned* FLAGS = (unsigned*)(a.ws + WS_FLAGS);
    for (int ph = 0; ph < NPHASES; ++ph) if (FLAGS[ph] > 0) { a.out[0] += 1000.f * (ph + 1) + (FLAGS[ph] > 100 ? 500.f : 0.f); return; }
}
#endif

extern "C" void kernel_launch(void* const* d_in, const int* in_sizes, int n_in, void* d_out, int out_size, void* d_ws, size_t ws_size, hipStream_t stream) {
    static int grid = 0;
    if (grid == 0) {
        if (n_in != 25 || out_size != ML * D || ws_size < WS_END) { fprintf(stderr, "kernel_launch: unexpected problem (n_in %d, out %d, ws %zu); nothing launched\n", n_in, out_size, ws_size); grid = -1; return; }
        int dev = 0, cus = 0, per_cu = 0;
        hipGetDevice(&dev); hipDeviceGetAttribute(&cus, hipDeviceAttributeMultiprocessorCount, dev);
        hipFuncSetAttribute((const void*)mk_fwd, hipFuncAttributeMaxDynamicSharedMemorySize, LDS_BYTES);
        hipOccupancyMaxActiveBlocksPerMultiprocessor(&per_cu, (const void*)mk_fwd, 512, LDS_BYTES);
        if (per_cu < 1) { fprintf(stderr, "kernel_launch: occupancy query says %d blocks per CU\n", per_cu); per_cu = 1; }
        (void)hipGetLastError();
        grid = cus * 1;
    }
    if (grid < 0) return;
    Args a{};
    for (int i = 0; i < 25; ++i) a.in[i] = (const float*)d_in[i];
    a.out = (float*)d_out; a.ws = (unsigned char*)d_ws;
#if MK_MULTI
#if defined(DBG_CHECK)
    hipMemsetAsync((char*)d_ws + WS_FLAGS, 0, 4096, stream);
#endif
    for (int p = 0; p < NPHASES; ++p) { a.ph_lo = p; a.ph_hi = p + 1;
#if defined(DBG_CHECK)
        hipLaunchKernelGGL(chk_kernel, dim3(NSAMP / 256), dim3(256), 0, stream, a, p, 0);
#endif
        hipLaunchKernelGGL(mk_fwd, dim3(grid), dim3(512), LDS_BYTES, stream, a);
#if defined(DBG_CHECK)
        hipLaunchKernelGGL(chk_kernel, dim3(NSAMP / 256), dim3(256), 0, stream, a, p, 1);
#endif
    }
#if defined(DBG_CHECK)
    hipLaunchKernelGGL(chk_report, dim3(1), dim3(1), 0, stream, a);
#endif
#else
    a.ph_lo = 0; a.ph_hi = NPHASES;
    hipMemsetAsync((char*)d_ws + WS_BAR, 0, 16384, stream);
    void* args[] = {&a};
    hipError_t e = hipLaunchCooperativeKernel((const void*)mk_fwd, dim3(grid), dim3(512), args, LDS_BYTES, stream);
    if (e != hipSuccess) fprintf(stderr, "cooperative launch failed: %s (grid %d)\n", hipGetErrorString(e), grid);
#endif
}
```

```cpp
#include <hip/hip_runtime.h>
#include <hip/hip_cooperative_groups.h>
#include <cstdio>
#include <cstdint>
namespace cg = cooperative_groups;

#ifndef SKIP_OP
#define SKIP_OP 99
#endif
#ifndef MK_MULTI
#define MK_MULTI 0
#endif

#define LAS __attribute__((address_space(3)))
typedef unsigned short bf16_t;
typedef short bf16x8 __attribute__((ext_vector_type(8)));
typedef short s16x4 __attribute__((ext_vector_type(4)));
typedef float f32x4 __attribute__((ext_vector_type(4)));
typedef float f32x2 __attribute__((ext_vector_type(2)));
typedef unsigned u32x4 __attribute__((ext_vector_type(4)));
typedef unsigned u32x2 __attribute__((ext_vector_type(2)));

constexpr int D = 1024, NB = 16, SEQ = 2048, CTX = 256, ML = NB * SEQ, MC = NB * CTX, MT = ML + MC, FF = 2816, NH = 16, HD = 64;
constexpr int MODW = 6 * D;
constexpr float EPS = 1e-6f, LOG2E = 1.4426950408889634f;
constexpr float QSCALE = 0.125f * LOG2E;
constexpr int LDS_BYTES = 155648;

constexpr size_t MiB = 1u << 20;
constexpr size_t WS_MOD = 0;
constexpr size_t WS_STATS = 2 * MiB;
constexpr size_t WS_WQKV = 7 * MiB;
constexpr size_t WS_WO = 19 * MiB;
constexpr size_t WS_WGU = 23 * MiB;
constexpr size_t WS_WDN = 67 * MiB;
constexpr size_t WS_WIN = 89 * MiB;
constexpr size_t WS_WOUT = 93 * MiB;
constexpr size_t WS_WPOOL = 95 * MiB;
constexpr size_t WS_XCTX = 96 * MiB;
constexpr size_t WS_H = 112 * MiB;
constexpr size_t WS_O = 184 * MiB;
constexpr size_t WS_BIG = 256 * MiB;
constexpr size_t WS_END = 472 * MiB;

__device__ __forceinline__ unsigned cvt_pk_bf16(float lo, float hi) { unsigned r; asm volatile("v_cvt_pk_bf16_f32 %0, %1, %2" : "=v"(r) : "v"(lo), "v"(hi)); return r; }
__device__ __forceinline__ float bf_lo(unsigned u) { return __uint_as_float(u << 16); }
__device__ __forceinline__ float bf_hi(unsigned u) { return __uint_as_float(u & 0xffff0000u); }
__device__ __forceinline__ float wave_sum(float v) {
#pragma unroll
    for (int o = 1; o < 64; o <<= 1) v += __shfl_xor(v, o);
    return v;
}
__device__ __forceinline__ float fast_rcp(float x) { return __builtin_amdgcn_rcpf(x); }
__device__ __forceinline__ float fast_exp2(float x) { return __builtin_amdgcn_exp2f(x); }
__device__ __forceinline__ float silu_f(float x) { return x * fast_rcp(1.0f + fast_exp2(-LOG2E * x)); }
__device__ __forceinline__ float gelu_tanh_f(float x) {
    const float y = 0.7978845608028654f * (x + 0.044715f * x * x * x);
    return x * fast_rcp(1.0f + fast_exp2(-2.0f * LOG2E * y));
}

namespace pg8 {
constexpr int BM = 256, BK = 64, HALF = 128, HTB = HALF * BK * 2, STAGE_BYTES = 8 * HTB, NXCD = 8, WGM = 8;
__host__ __device__ __forceinline__ int lds_byte(int r, int c) { const int st = (r >> 4) * 2 + (c >> 5), rr = r & 15, cc = c & 31, ob = rr * 64 + cc * 2; return st * 1024 + (ob ^ (((ob >> 9) & 1) << 5)); }
__host__ __device__ __forceinline__ void stage_rc(int b, int& R, int& C) { const int st = b / 1024, sb = b % 1024, swz = sb ^ (((sb >> 9) & 1) << 5); R = (st >> 1) * 16 + swz / 64; C = (st & 1) * 32 + (swz % 64) / 2; }
__host__ __device__ __forceinline__ int perm32(int rho) { const int n = rho >> 4, i = rho & 15; return 8 * (i >> 2) + 4 * n + (i & 3); }

struct Unit { int pm, pn, k0, nt, split; };
struct Gemm { const bf16_t* A; const bf16_t* Bt; int M, N, K, lda, a_pn_off; };

struct StaticOrder {
    int nM, nN, nwg, G, c, ntf, nx;
    __device__ void init(int M, int N, int K, int G_, int c_, int Mextra = 0) { nM = M / BM; nN = N / BM; nwg = nM * nN; G = G_; c = c_; ntf = K / BK; nx = (Mextra / BM) * nN * 4; }
    __device__ bool next(int i, Unit& u) const {
        const long L = (long)i * G + c;
        if (L >= nwg) { const int e = (int)(L - nwg); if (e >= nx) return false;
            const int q = e & 3, tile = e >> 2, base = (ntf >> 2) & ~1, rem2 = (ntf - 4 * base) >> 1;
            u.pm = nM + tile / nN; u.pn = tile % nN; u.k0 = q * base + 2 * (q < rem2 ? q : rem2); u.nt = base + (q < rem2 ? 2 : 0); u.split = q + 1; return true; }
        int wgid = (int)L; { const int q = nwg / NXCD, r = nwg % NXCD, xcd = wgid % NXCD, off = wgid / NXCD; wgid = (xcd < r ? xcd * (q + 1) : r * (q + 1) + (xcd - r) * q) + off; }
        const int nig = WGM * nN, gid = wgid / nig, fm = gid * WGM, gsz = (nM - fm) < WGM ? (nM - fm) : WGM;
        u.pm = fm + ((wgid % nig) % gsz); u.pn = (wgid % nig) / gsz; u.k0 = 0; u.nt = ntf; u.split = 0; return true;
    }
};

template <class Epi>
__device__ __forceinline__ void gemm_phase(LAS unsigned char* lds, const Gemm g, const StaticOrder& S, const Epi& E, const int tid) {
    const int wid = __builtin_amdgcn_readfirstlane(tid >> 6), lane = tid & 63, wr = wid >> 2, wc = wid & 3, fr = lane & 15, fq = lane >> 4;
    const int K = g.K, lda = g.lda;
    unsigned voffA[2], voffB[2];
#pragma unroll
    for (int i = 0; i < 2; ++i) { int R, C; stage_rc(tid * 16 + i * 8192, R, C); const int Rb = Epi::PERM ? ((R & ~31) + perm32(R & 31)) : R;
        voffA[i] = (unsigned)(R * lda + C) * 2u; voffB[i] = (unsigned)(Rb * K + C) * 2u; }
    const size_t kstep = (size_t)(BK * 2);
    const size_t hstepA = (size_t)HALF * lda * 2, hstepB = (size_t)HALF * K * 2;
    const size_t tstepA = 2 * hstepA, tstepB = 2 * hstepB;
    const unsigned ldsw = (unsigned)wid * 1024u;
    const int aoff = lds_byte(wr * 64 + fr, fq * 8), boff = lds_byte(wc * 32 + fr, fq * 8);
#define PG8_SA(b, h) (((b) * 2 + (h)) * HTB)
#define PG8_SB(b, h) ((4 + (b) * 2 + (h)) * HTB)
#define PG8_STAGE(bufoff, gbase, voff) do { _Pragma("unroll") for (int _i = 0; _i < 2; ++_i) \
        __builtin_amdgcn_global_load_lds((const unsigned*)((const char*)(gbase) + (voff)[_i]), (LAS unsigned*)(lds + (bufoff) + ldsw + _i * 8192), 16, 0, 0); } while (0)
#define PG8_LDA(dst, b, h) do { _Pragma("unroll") for (int m = 0; m < 4; ++m) _Pragma("unroll") for (int k = 0; k < 2; ++k) dst[m][k] = *(const LAS bf16x8*)(lds + PG8_SA(b, h) + aoff + m * 2048 + k * 1024); } while (0)
#define PG8_LDB(dst, b, h) do { _Pragma("unroll") for (int n = 0; n < 2; ++n) _Pragma("unroll") for (int k = 0; k < 2; ++k) dst[n][k] = *(const LAS bf16x8*)(lds + PG8_SB(b, h) + boff + n * 2048 + k * 1024); } while (0)
#define PG8_MMA(ai, bj, At, Bt) do { __builtin_amdgcn_s_setprio(1); _Pragma("unroll") for (int m = 0; m < 4; ++m) _Pragma("unroll") for (int n = 0; n < 2; ++n) _Pragma("unroll") for (int k = 0; k < 2; ++k) \
        acc[ai][bj][m][n] = __builtin_amdgcn_mfma_f32_16x16x32_bf16(Bt[n][k], At[m][k], acc[ai][bj][m][n], 0, 0, 0); __builtin_amdgcn_s_setprio(0); } while (0)
#define PG8_WAIT_V(n) asm volatile("s_waitcnt vmcnt(" #n ")" ::: "memory")
#define PG8_WAIT_L(n) asm volatile("s_waitcnt lgkmcnt(" #n ")" ::: "memory")
#define PG8_BAR __builtin_amdgcn_s_barrier()
#define PG8_SCHED __builtin_amdgcn_sched_barrier(0)
    Unit cur, nxt; int ui = 0;
    if (!S.next(0, cur)) return;
    f32x4 acc[2][2][4][2];
#pragma unroll
    for (int a = 0; a < 2; ++a)
#pragma unroll
        for (int b = 0; b < 2; ++b)
#pragma unroll
            for (int m = 0; m < 4; ++m)
#pragma unroll
                for (int n = 0; n < 2; ++n) acc[a][b][m][n] = (f32x4){0.f, 0.f, 0.f, 0.f};
    bf16x8 At[4][2], B0[2][2], B1[2][2];
    const char* cA = (const char*)g.A + (size_t)cur.pm * tstepA + (size_t)cur.pn * g.a_pn_off + (size_t)cur.k0 * kstep; const char* cB = (const char*)g.Bt + (size_t)cur.pn * tstepB + (size_t)cur.k0 * kstep;
    PG8_STAGE(PG8_SB(0, 0), cB, voffB); PG8_STAGE(PG8_SB(0, 1), cB + hstepB, voffB); PG8_STAGE(PG8_SA(0, 0), cA, voffA); PG8_STAGE(PG8_SA(0, 1), cA + hstepA, voffA);
    if (wr == 1) PG8_BAR;
    PG8_WAIT_V(2); PG8_BAR;
    PG8_STAGE(PG8_SB(1, 0), cB + kstep, voffB); PG8_STAGE(PG8_SA(1, 0), cA + kstep, voffA); PG8_STAGE(PG8_SB(1, 1), cB + hstepB + kstep, voffB);
    PG8_WAIT_V(6); PG8_BAR;
    for (;;) {
        const bool has_next = S.next(ui + 1, nxt);
        const char* nA = has_next ? (const char*)g.A + (size_t)nxt.pm * tstepA + (size_t)nxt.pn * g.a_pn_off + (size_t)nxt.k0 * kstep : cA; const char* nB = has_next ? (const char*)g.Bt + (size_t)nxt.pn * tstepB + (size_t)nxt.k0 * kstep : cB;
        const int nt = cur.nt;
        for (int t = 0; t < nt; t += 2) {
            const bool last = (t == nt - 2);
            const char* a1 = cA + (size_t)(t + 1) * kstep;
            const char* a2 = last ? nA : cA + (size_t)(t + 2) * kstep; const char* b2 = last ? nB : cB + (size_t)(t + 2) * kstep;
            const char* a3 = a2 + kstep; const char* b3 = b2 + kstep;
            PG8_LDB(B0, 0, 0); PG8_LDB(B1, 0, 1); PG8_SCHED; PG8_LDA(At, 0, 0); PG8_STAGE(PG8_SA(1, 1), a1 + hstepA, voffA);
            PG8_WAIT_V(8); PG8_WAIT_L(0); PG8_BAR; PG8_MMA(0, 0, At, B0); PG8_MMA(0, 1, At, B1); PG8_BAR; PG8_SCHED;
            PG8_LDA(At, 0, 1); PG8_STAGE(PG8_SB(0, 0), b2, voffB); PG8_STAGE(PG8_SB(0, 1), b2 + hstepB, voffB); PG8_STAGE(PG8_SA(0, 0), a2, voffA);
            PG8_WAIT_V(8); PG8_WAIT_L(0); PG8_BAR; PG8_MMA(1, 0, At, B0); PG8_MMA(1, 1, At, B1); PG8_BAR; PG8_SCHED;
            PG8_LDB(B0, 1, 0); PG8_LDB(B1, 1, 1); PG8_SCHED; PG8_LDA(At, 1, 0); PG8_STAGE(PG8_SA(0, 1), a2 + hstepA, voffA);
            PG8_WAIT_V(8); PG8_WAIT_L(0); PG8_BAR; PG8_MMA(0, 0, At, B0); PG8_MMA(0, 1, At, B1); PG8_BAR; PG8_SCHED;
            PG8_LDA(At, 1, 1); PG8_STAGE(PG8_SB(1, 0), b3, voffB); PG8_STAGE(PG8_SB(1, 1), b3 + hstepB, voffB); PG8_STAGE(PG8_SA(1, 0), a3, voffA);
            PG8_WAIT_V(8); PG8_WAIT_L(0); PG8_BAR; PG8_MMA(1, 0, At, B0); PG8_MMA(1, 1, At, B1); PG8_BAR; PG8_SCHED;
        }
        if (wr == 0) PG8_BAR;
        E(acc, cur, wr, wc, fr, fq);
        if (!has_next) break;
#pragma unroll
        for (int a = 0; a < 2; ++a)
#pragma unroll
            for (int b = 0; b < 2; ++b)
#pragma unroll
                for (int m = 0; m < 4; ++m)
#pragma unroll
                    for (int n = 0; n < 2; ++n) acc[a][b][m][n] = (f32x4){0.f, 0.f, 0.f, 0.f};
        cur = nxt; cA = nA; cB = nB; ++ui;
        if (wr == 1) PG8_BAR;
    }
    PG8_WAIT_V(0);
    PG8_BAR;
#undef PG8_SA
#undef PG8_SB
#undef PG8_STAGE
#undef PG8_LDA
#undef PG8_LDB
#undef PG8_MMA
#undef PG8_WAIT_V
#undef PG8_WAIT_L
#undef PG8_BAR
#undef PG8_SCHED
}
}
using pg8::Unit;

struct EpiQKV {
    static constexpr bool PERM = true;
    bf16_t* O; const float* qg; const float* kg;
    __device__ __forceinline__ void operator()(const f32x4 (&acc)[2][2][4][2], const Unit& u, int wr, int wc, int fr, int fq) const {
        const int kind = u.pn >> 2;
        const int colbase = u.pn * 256 + wc * 64 + 8 * fq;
        f32x4 gv[2][2];
#pragma unroll
        for (int bj = 0; bj < 2; ++bj)
#pragma unroll
            for (int n = 0; n < 2; ++n) {
                gv[bj][n] = (f32x4){1.f, 1.f, 1.f, 1.f};
                if (kind < 2) gv[bj][n] = *(const f32x4*)((kind == 0 ? qg : kg) + 32 * bj + 8 * fq + 4 * n);
            }
        const float post = kind == 0 ? QSCALE : 1.0f;
#pragma unroll
        for (int ai = 0; ai < 2; ++ai)
#pragma unroll
            for (int m = 0; m < 4; ++m) {
                const int row = u.pm * 256 + ai * 128 + wr * 64 + m * 16 + fr;
                f32x4 v[2][2];
#pragma unroll
                for (int bj = 0; bj < 2; ++bj)
#pragma unroll
                    for (int n = 0; n < 2; ++n) v[bj][n] = acc[ai][bj][m][n];
                if (kind < 2) {
                    float ss = 0.f;
#pragma unroll
                    for (int bj = 0; bj < 2; ++bj)
#pragma unroll
                        for (int n = 0; n < 2; ++n) ss += (v[bj][n][0] * v[bj][n][0] + v[bj][n][1] * v[bj][n][1]) + (v[bj][n][2] * v[bj][n][2] + v[bj][n][3] * v[bj][n][3]);
                    ss += __shfl_xor(ss, 16); ss += __shfl_xor(ss, 32);
                    const float rs = __builtin_amdgcn_rsqf(ss * (1.0f / 64.0f) + EPS) * post;
#pragma unroll
                    for (int bj = 0; bj < 2; ++bj)
#pragma unroll
                        for (int n = 0; n < 2; ++n) v[bj][n] = v[bj][n] * rs * gv[bj][n];
                }
                bf16_t* rowp = O + (size_t)row * 3072 + colbase;
#pragma unroll
                for (int bj = 0; bj < 2; ++bj) {
                    u32x4 w; w.x = cvt_pk_bf16(v[bj][0][0], v[bj][0][1]); w.y = cvt_pk_bf16(v[bj][0][2], v[bj][0][3]); w.z = cvt_pk_bf16(v[bj][1][0], v[bj][1][1]); w.w = cvt_pk_bf16(v[bj][1][2], v[bj][1][3]);
                    *(u32x4*)(rowp + 32 * bj) = w; }
            }
    }
};
struct EpiResid {
    static constexpr bool PERM = false;
    const float* base_lat; const float* base_ctx; float* out_lat; float* out_ctx; const float* mod; const float* cscale; float* part;
    __device__ __forceinline__ void operator()(const f32x4 (&acc)[2][2][4][2], const Unit& u, int wr, int wc, int fr, int fq) const {
        const bool lat = u.pm < (ML / 256); const int bidx = lat ? (u.pm >> 3) : NB;
        const float* base = lat ? base_lat : base_ctx; float* out = lat ? out_lat : out_ctx;
        const float* gp = mod + (size_t)bidx * MODW;
        const int col0 = u.pn * 256 + wc * 32 + 4 * fq;
        f32x4 gt[2][2];
#pragma unroll
        for (int bj = 0; bj < 2; ++bj)
#pragma unroll
            for (int n = 0; n < 2; ++n) { gt[bj][n] = *(const f32x4*)(gp + col0 + bj * 128 + n * 16); if (cscale) gt[bj][n] = gt[bj][n] * *(const f32x4*)(cscale + col0 + bj * 128 + n * 16); }
        if (u.split) {
            float* pb = part + (size_t)(u.split - 1) * MC * D - (size_t)ML * D;
#pragma unroll
            for (int ai = 0; ai < 2; ++ai)
#pragma unroll
                for (int m = 0; m < 4; ++m) {
                    float* op = pb + (size_t)(u.pm * 256 + ai * 128 + wr * 64 + m * 16 + fr) * D + col0;
#pragma unroll
                    for (int bj = 0; bj < 2; ++bj)
#pragma unroll
                        for (int n = 0; n < 2; ++n) *(f32x4*)(op + bj * 128 + n * 16) = gt[bj][n] * acc[ai][bj][m][n];
                }
            return;
        }
#pragma unroll
        for (int ai = 0; ai < 2; ++ai)
#pragma unroll
            for (int m = 0; m < 4; ++m) {
                const size_t off = (size_t)(u.pm * 256 + ai * 128 + wr * 64 + m * 16 + fr) * D + col0;
#pragma unroll
                for (int bj = 0; bj < 2; ++bj)
#pragma unroll
                    for (int n = 0; n < 2; ++n) { const f32x4 bs = *(const f32x4*)(base + off + bj * 128 + n * 16); *(f32x4*)(out + off + bj * 128 + n * 16) = bs + gt[bj][n] * acc[ai][bj][m][n]; }
                asm volatile("" ::: "memory");
            }
    }
};
struct EpiSwiGLU {
    static constexpr bool PERM = true;
    bf16_t* G;
    __device__ __forceinline__ void operator()(const f32x4 (&acc)[2][2][4][2], const Unit& u, int wr, int wc, int fr, int fq) const {
        const int col = u.pn * 128 + wc * 32 + 8 * fq;
#pragma unroll
        for (int ai = 0; ai < 2; ++ai)
#pragma unroll
            for (int m = 0; m < 4; ++m) {
                const int row = u.pm * 256 + ai * 128 + wr * 64 + m * 16 + fr;
                float h[8];
#pragma unroll
                for (int n = 0; n < 2; ++n)
#pragma unroll
                    for (int e = 0; e < 4; ++e) h[4 * n + e] = silu_f(acc[ai][0][m][n][e]) * acc[ai][1][m][n][e];
                u32x4 w; w.x = cvt_pk_bf16(h[0], h[1]); w.y = cvt_pk_bf16(h[2], h[3]); w.z = cvt_pk_bf16(h[4], h[5]); w.w = cvt_pk_bf16(h[6], h[7]);
                *(u32x4*)(G + (size_t)row * FF + col) = w;
            }
    }
};
struct EpiGelu {
    static constexpr bool PERM = true;
    bf16_t* Z; const float* bias; float* stats;
    __device__ __forceinline__ void operator()(const f32x4 (&acc)[2][2][4][2], const Unit& u, int wr, int wc, int fr, int fq) const {
        const int col0 = u.pn * 256 + wc * 32 + 8 * fq;
        f32x4 bv[2][2];
#pragma unroll
        for (int bj = 0; bj < 2; ++bj)
#pragma unroll
            for (int n = 0; n < 2; ++n) bv[bj][n] = *(const f32x4*)(bias + col0 + bj * 128 + 4 * n);
#pragma unroll
        for (int ai = 0; ai < 2; ++ai)
#pragma unroll
            for (int m = 0; m < 4; ++m) {
                const int row = u.pm * 256 + ai * 128 + wr * 64 + m * 16 + fr;
                float s = 0.f, ss = 0.f;
#pragma unroll
                for (int bj = 0; bj < 2; ++bj) {
                    float h[8];
#pragma unroll
                    for (int n = 0; n < 2; ++n)
#pragma unroll
                        for (int e = 0; e < 4; ++e) { const float x = gelu_tanh_f(acc[ai][bj][m][n][e] + bv[bj][n][e]); h[4 * n + e] = x; s += x; ss += x * x; }
                    u32x4 w; w.x = cvt_pk_bf16(h[0], h[1]); w.y = cvt_pk_bf16(h[2], h[3]); w.z = cvt_pk_bf16(h[4], h[5]); w.w = cvt_pk_bf16(h[6], h[7]);
                    *(u32x4*)(Z + (size_t)row * 2048 + col0 + bj * 128) = w;
                }
                if (u.pn >= 4) {
                    s += __shfl_xor(s, 16); s += __shfl_xor(s, 32); ss += __shfl_xor(ss, 16); ss += __shfl_xor(ss, 32);
                    if (fq == 0) *(f32x2*)(stats + ((size_t)row * 16 + (u.pn - 4) * 4 + wc) * 2) = (f32x2){s, ss};
                }
            }
    }
};

struct Args {
    const float* in[25];
    float* out; unsigned char* ws;
    int ph_lo, ph_hi;
};
enum { I_X = 0, I_C, I_CTX, I_CCTX, I_ADAW, I_ADAB, I_N1G, I_N2G, I_WG, I_WU, I_WD, I_WQKV, I_WO, I_QN, I_KN, I_RPB, I_GWIN, I_GBIN, I_GLNG, I_GLNB, I_GWS, I_GBS, I_GWOUT, I_PW, I_PS };

__device__ __forceinline__ unsigned f2bf(float f) { unsigned u = __builtin_bit_cast(unsigned, f); return (u + 0x7fffu + ((u >> 16) & 1u)) >> 16; }
__device__ __forceinline__ unsigned pk2(float lo, float hi) { return f2bf(lo) | (f2bf(hi) << 16); }
__device__ __forceinline__ void p0_transpose_item(const float* W, int K, int N, bf16_t* WT, int mode, int row_off, LAS float* scr, int item, int lane) {
    const int nblk = N / 32, kb = item / nblk, nb = item % nblk, k0 = 64 * kb, n0 = 32 * nb;
#pragma unroll 8
    for (int i = 0; i < 32; ++i) { const int kk = 2 * i + (lane >> 5); scr[kk * 33 + (lane & 31)] = W[(size_t)(k0 + kk) * N + n0 + (lane & 31)]; }
    asm volatile("s_waitcnt lgkmcnt(0)" ::: "memory");
    int r0;
    if (mode == 0) r0 = row_off + n0;
    else if (mode == 1) { const int pn = n0 >> 8, lc = n0 & 255; r0 = pn * 256 + 128 * ((lc & 63) >> 5) + 32 * (lc >> 6); }
    else r0 = (n0 >> 7) * 256 + (n0 & 127) + row_off;
    const int c = lane & 7;
#pragma unroll
    for (int j = 0; j < 4; ++j) { const int n = (lane >> 3) + 8 * j; const LAS float* s = scr + (8 * c) * 33 + n;
        u32x4 o; o.x = pk2(s[0 * 33], s[1 * 33]); o.y = pk2(s[2 * 33], s[3 * 33]); o.z = pk2(s[4 * 33], s[5 * 33]); o.w = pk2(s[6 * 33], s[7 * 33]);
        *(u32x4*)(WT + (size_t)(r0 + n) * K + k0 + 8 * c) = o; }
    asm volatile("s_waitcnt lgkmcnt(0)" ::: "memory");
}

typedef const __attribute__((address_space(4))) Args* ArgsP;
__device__ __forceinline__ void p0_prologue(ArgsP ap, LAS unsigned char* lds, int G, int bid, const int tid) {
    const int lane = tid & 63, w = __builtin_amdgcn_readfirstlane(tid >> 6);
    unsigned char* ws = ap->ws;
    if (bid < 384) {
        LAS float* S17 = (LAS float*)lds; LAS float* RED = (LAS float*)(lds + 17 * 1024 * 4);
        for (int e = tid; e < 17 * 1024; e += 512) { const int b = e >> 10, k = e & 1023; const float x = b < 16 ? ap->in[I_C][b * 1024 + k] : ap->in[I_CCTX][k]; S17[e] = x / (1.0f + __expf(-x)); }
        __syncthreads();
        float* MOD = (float*)(ws + WS_MOD);
        for (int item = bid; item < 384; item += G) {
            const int i = item / 96, cb = item % 96;
            const float* wp = ap->in[I_ADAW] + ((size_t)i * 1024 + w * 128) * MODW + cb * 64 + lane;
            float acc[17];
#pragma unroll
            for (int b = 0; b < 17; ++b) acc[b] = 0.f;
            for (int k0 = 0; k0 < 128; k0 += 8) {
                float wv[8];
#pragma unroll
                for (int u = 0; u < 8; ++u) wv[u] = wp[(size_t)(k0 + u) * MODW];
#pragma unroll
                for (int u4 = 0; u4 < 2; ++u4)
#pragma unroll
                    for (int b = 0; b < 17; ++b) { const f32x4 s = *(const LAS f32x4*)(S17 + b * 1024 + w * 128 + k0 + 4 * u4);
                        acc[b] += (s[0] * wv[4 * u4] + s[1] * wv[4 * u4 + 1]) + (s[2] * wv[4 * u4 + 2] + s[3] * wv[4 * u4 + 3]); }
            }
#pragma unroll
            for (int b = 0; b < 17; ++b) RED[(w * 17 + b) * 64 + lane] = acc[b];
            __syncthreads();
            for (int o = tid; o < 17 * 64; o += 512) { const int b = o >> 6, ln = o & 63; float s = 0.f;
#pragma unroll
                for (int ww = 0; ww < 8; ++ww) s += RED[(ww * 17 + b) * 64 + ln];
                MOD[((size_t)i * 17 + b) * MODW + cb * 64 + ln] = s + ap->in[I_ADAB][i * MODW + cb * 64 + ln]; }
            __syncthreads();
        }
    }
    __syncthreads();
    LAS float* scr = (LAS float*)(lds + w * 16384);
    const int gw = bid * 8 + w, NGW = G * 8;
    constexpr int I_QKV = 16 * 96, I_SQ = 16 * 32, I_GU = 16 * 88, I_DN = 44 * 32, I_IN = 16 * 64, I_PL = 4 * 8;
    constexpr int NITEMS = 2 * I_QKV + 2 * I_SQ + 8 * I_GU + 4 * I_DN + I_IN + I_SQ + 4 * I_PL;
    for (int it = gw; it < NITEMS; it += NGW) {
        int r = it;
        if (r < 2 * I_QKV) { const int j = r / I_QKV; p0_transpose_item(ap->in[I_WQKV] + (size_t)j * D * 3072, D, 3072, (bf16_t*)(ws + WS_WQKV) + (size_t)j * 3072 * D, 1, 0, scr, r % I_QKV, lane); continue; } r -= 2 * I_QKV;
        if (r < 2 * I_SQ) { const int j = r / I_SQ; p0_transpose_item(ap->in[I_WO] + (size_t)j * D * D, D, D, (bf16_t*)(ws + WS_WO) + (size_t)j * D * D, 0, 0, scr, r % I_SQ, lane); continue; } r -= 2 * I_SQ;
        if (r < 8 * I_GU) { const int i = r / (2 * I_GU), gu = (r / I_GU) & 1; p0_transpose_item(ap->in[gu ? I_WU : I_WG] + (size_t)i * D * FF, D, FF, (bf16_t*)(ws + WS_WGU) + (size_t)i * 2 * FF * D, 2, gu * 128, scr, r % I_GU, lane); continue; } r -= 8 * I_GU;
        if (r < 4 * I_DN) { const int i = r / I_DN; p0_transpose_item(ap->in[I_WD] + (size_t)i * FF * D, FF, D, (bf16_t*)(ws + WS_WDN) + (size_t)i * D * FF, 0, 0, scr, r % I_DN, lane); continue; } r -= 4 * I_DN;
        if (r < I_IN) { p0_transpose_item(ap->in[I_GWIN], D, 2048, (bf16_t*)(ws + WS_WIN), 0, 0, scr, r, lane); continue; } r -= I_IN;
        if (r < I_SQ) { p0_transpose_item(ap->in[I_GWOUT], D, D, (bf16_t*)(ws + WS_WOUT), 0, 0, scr, r, lane); continue; } r -= I_SQ;
        { const int g = r / I_PL; p0_transpose_item(ap->in[I_PW] + (size_t)g * 256 * 256, 256, 256, (bf16_t*)(ws + WS_WPOOL), 0, g * 256, scr, r % I_PL, lane); }
    }
}

template <int NR>
__device__ __forceinline__ void norm_group(int m0, const float* xl, const float* xc, const float* gvec, const float* modl, int sh_off, int sc_off, bf16_t* Hout, int lane, float* cpl, float* cpc, const float* pend) {
    const bool lat = m0 < ML; const int bidx = lat ? (m0 >> 11) : NB;
    const float* xr = (lat ? xl : xc) + (size_t)m0 * D + 4 * lane;
    const float* mp = modl + (size_t)bidx * MODW;
    f32x4 v[NR][4]; float ss[NR];
#pragma unroll
    for (int r = 0; r < NR; ++r)
#pragma unroll
        for (int j = 0; j < 4; ++j) v[r][j] = __builtin_nontemporal_load((const f32x4*)(xr + (size_t)r * D + 256 * j));
    if (pend && !lat) {
        const float* pp = pend + (size_t)(m0 - ML) * D + 4 * lane; float* xw = const_cast<float*>(xr);
#pragma unroll
        for (int q = 0; q < 4; ++q)
#pragma unroll
            for (int r = 0; r < NR; ++r)
#pragma unroll
                for (int j = 0; j < 4; ++j) v[r][j] += __builtin_nontemporal_load((const f32x4*)(pp + (size_t)q * MC * D + (size_t)r * D + 256 * j));
#pragma unroll
        for (int r = 0; r < NR; ++r)
#pragma unroll
            for (int j = 0; j < 4; ++j) *(f32x4*)(xw + (size_t)r * D + 256 * j) = v[r][j];
    }
    if (cpl) {
        float* cp = (lat ? cpl : cpc) + (size_t)m0 * D + 4 * lane;
#pragma unroll
        for (int r = 0; r < NR; ++r)
#pragma unroll
            for (int j = 0; j < 4; ++j) *(f32x4*)(cp + (size_t)r * D + 256 * j) = v[r][j];
    }
#pragma unroll
    for (int r = 0; r < NR; ++r) { float s = 0.f;
#pragma unroll
        for (int j = 0; j < 4; ++j) s += (v[r][j][0] * v[r][j][0] + v[r][j][1] * v[r][j][1]) + (v[r][j][2] * v[r][j][2] + v[r][j][3] * v[r][j][3]);
        ss[r] = s; }
#pragma unroll
    for (int o = 1; o < 64; o <<= 1) {
#pragma unroll
        for (int r = 0; r < NR; ++r) ss[r] += __shfl_xor(ss[r], o);
    }
    float rstd[NR];
#pragma unroll
    for (int r = 0; r < NR; ++r) rstd[r] = __builtin_amdgcn_rsqf(ss[r] * (1.0f / D) + EPS);
#pragma unroll
    for (int j = 0; j < 4; ++j) { const int c = 4 * lane + 256 * j;
        const f32x4 g4 = *(const f32x4*)(gvec + c), sc4 = *(const f32x4*)(mp + sc_off + c), sh4 = *(const f32x4*)(mp + sh_off + c);
        const f32x4 gm = g4 * (sc4 + 1.0f);
#pragma unroll
        for (int r = 0; r < NR; ++r) { const f32x4 o = v[r][j] * rstd[r] * gm + sh4;
            u32x2 pk; pk.x = cvt_pk_bf16(o[0], o[1]); pk.y = cvt_pk_bf16(o[2], o[3]);
            *(u32x2*)(Hout + (size_t)(m0 + r) * D + c) = pk; }
    }
}
__device__ __forceinline__ void norm_phase(const float* xl, const float* xc, const float* gvec, const float* modl, int sh_off, int sc_off, bf16_t* Hout, int Mrows, int G, int bid, const int tid, float* cpl, float* cpc, const float* pend) {
    const int lane = tid & 63, w = tid >> 6;
    const int gw = bid * 8 + w, NGW = G * 8;
    const int Mlat = Mrows < ML ? Mrows : ML;
    for (int m0 = gw * 4; m0 < Mlat; m0 += NGW * 4) norm_group<4>(m0, xl, xc, gvec, modl, sh_off, sc_off, Hout, lane, cpl, cpc, nullptr);
    for (int m0 = ML + gw * 2; m0 < Mrows; m0 += NGW * 2) norm_group<2>(m0, xl, xc, gvec, modl, sh_off, sc_off, Hout, lane, cpl, cpc, pend);
}

constexpr int KP = 144, VP = 136;
constexpr int A_CK = 0, A_CV = A_CK + CTX * KP, A_LV = A_CV + CTX * VP, LV_SLOT = 64 * VP, A_RPB = A_LV + 9 * LV_SLOT, A_END = A_RPB + 15 * 64 * 4;
static_assert(A_END <= LDS_BYTES, "attention LDS map");

__device__ __forceinline__ s16x4 vtr(unsigned addr) { return __builtin_bit_cast(s16x4, __builtin_amdgcn_ds_read_tr16_b64_v4i16((LAS s16x4*)(uintptr_t)addr)); }

struct AttnState { f32x4 o[4]; float l; };
__device__ __forceinline__ void qk_chunk(float (&s)[8], bf16x8 k00, bf16x8 k01, bf16x8 k10, bf16x8 k11, bf16x8 q0, bf16x8 q1, float negm) {
    f32x4 z = (f32x4){negm, negm, negm, negm};
    f32x4 s0 = __builtin_amdgcn_mfma_f32_16x16x32_bf16(k00, q0, z, 0, 0, 0); s0 = __builtin_amdgcn_mfma_f32_16x16x32_bf16(k01, q1, s0, 0, 0, 0);
    f32x4 s1 = __builtin_amdgcn_mfma_f32_16x16x32_bf16(k10, q0, z, 0, 0, 0); s1 = __builtin_amdgcn_mfma_f32_16x16x32_bf16(k11, q1, s1, 0, 0, 0);
    s[0] = s0[0]; s[1] = s0[1]; s[2] = s0[2]; s[3] = s0[3]; s[4] = s1[0]; s[5] = s1[1]; s[6] = s1[2]; s[7] = s1[3];
}
__device__ __forceinline__ void qk_chunk_c(float (&s)[8], bf16x8 k00, bf16x8 k01, bf16x8 k10, bf16x8 k11, bf16x8 q0, bf16x8 q1, f32x4 c0, f32x4 c1) {
    f32x4 s0 = __builtin_amdgcn_mfma_f32_16x16x32_bf16(k00, q0, c0, 0, 0, 0); s0 = __builtin_amdgcn_mfma_f32_16x16x32_bf16(k01, q1, s0, 0, 0, 0);
    f32x4 s1 = __builtin_amdgcn_mfma_f32_16x16x32_bf16(k10, q0, c1, 0, 0, 0); s1 = __builtin_amdgcn_mfma_f32_16x16x32_bf16(k11, q1, s1, 0, 0, 0);
    s[0] = s0[0]; s[1] = s0[1]; s[2] = s0[2]; s[3] = s0[3]; s[4] = s1[0]; s[5] = s1[1]; s[6] = s1[2]; s[7] = s1[3];
}
__device__ __forceinline__ void softmax_pv(AttnState& st, const float (&s)[8], unsigned vaddr, float mq) {
    float p[8]; float ls = 0.f;
#pragma unroll
    for (int j = 0; j < 8; ++j) { p[j] = fast_exp2(s[j]); ls += p[j]; }
    st.l += ls;
    u32x4 pw; pw.x = cvt_pk_bf16(p[0], p[1]); pw.y = cvt_pk_bf16(p[2], p[3]); pw.z = cvt_pk_bf16(p[4], p[5]); pw.w = cvt_pk_bf16(p[6], p[7]);
    const bf16x8 pf = __builtin_bit_cast(bf16x8, pw);
#pragma unroll
    for (int db = 0; db < 4; ++db) {
        const s16x4 lo = vtr(vaddr + db * 32), hi = vtr(vaddr + db * 32 + 4 * VP);
        const bf16x8 vf = (bf16x8){lo[0], lo[1], lo[2], lo[3], hi[0], hi[1], hi[2], hi[3]};
        st.o[db] = __builtin_amdgcn_mfma_f32_16x16x32_bf16(vf, pf, st.o[db], 0, 0, 0);
    }
}

template <bool LOCAL>
__device__ __forceinline__ void attn_unit(LAS unsigned char* lds, const bf16_t* QKV, bf16_t* O, int qtok0, int h, int b, int r, int rs, int j, int lane, float kmax, float bmax) {
    const int fr = lane & 15, fq = lane >> 4;
    const unsigned lbase = (unsigned)(uintptr_t)lds;
    const bf16_t* qp = QKV + (size_t)(qtok0 + fr) * 3072 + h * 64 + 8 * fq;
    const u32x4 qw0 = *(const u32x4*)qp, qw1 = *(const u32x4*)(qp + 32);
    const bf16x8 q0 = __builtin_bit_cast(bf16x8, qw0), q1 = __builtin_bit_cast(bf16x8, qw1);
    const int kc0 = min(max(16 * j - 8, 0), 32);
    const int krow0 = 8 * (fr >> 2) + (fr & 3);
    bf16x8 kl[4][2][2];
    const bf16_t* kbase = QKV + (size_t)(b * SEQ + rs * 64 + kc0 + krow0) * 3072 + 1024 + h * 64 + 8 * fq;
#define LOADK(i) do { _Pragma("unroll") for (int t = 0; t < 2; ++t) { const bf16_t* kp = kbase + (size_t)((i) * 64 + 4 * t) * 3072; kl[(i) & 3][t][0] = *(const bf16x8*)kp; kl[(i) & 3][t][1] = *(const bf16x8*)(kp + 32); } } while (0)
    if (LOCAL) {
#pragma unroll
        for (int i = 0; i < 4; ++i) LOADK(i);
    }
    float qn = 0.f;
    { const unsigned qq[8] = {qw0.x, qw0.y, qw0.z, qw0.w, qw1.x, qw1.y, qw1.z, qw1.w};
#pragma unroll
      for (int e = 0; e < 8; ++e) { const float a = bf_lo(qq[e]), c = bf_hi(qq[e]); qn += a * a + c * c; } }
    qn += __shfl_xor(qn, 16); qn += __shfl_xor(qn, 32);
    const float mq = __builtin_sqrtf(qn) * kmax + (LOCAL ? bmax : 0.f);
    f32x4 bm[8][2];
    if (LOCAL) {
        const int qcol = 16 * j + fr, cstart = min(max(qcol - 8, 0), 48);
        const int kcol0 = kc0 + 8 * fq;
        const LAS float* rp = (const LAS float*)(lds + A_RPB) + (kcol0 - qcol + 15 + 16) + (rs - r + 7) * 64;
        float mk[8];
#pragma unroll
        for (int e = 0; e < 8; ++e) mk[e] = ((unsigned)(kcol0 + e - cstart) < 16u) ? -mq : -1e30f;
#pragma unroll
        for (int i = 0; i < 8; ++i)
#pragma unroll
            for (int e = 0; e < 8; ++e) bm[i][e >> 2][e & 3] = rp[i * 64 + e] + mk[e];
    }
    AttnState st;
#pragma unroll
    for (int db = 0; db < 4; ++db) st.o[db] = (f32x4){0.f, 0.f, 0.f, 0.f};
    st.l = 0.f;
    const unsigned vsub = (unsigned)((8 * fq + (fr >> 2)) * VP + 8 * (fr & 3));
#pragma unroll 2
    for (int c = 0; c < 8; ++c) {
        const LAS unsigned char* kb = lds + A_CK + (32 * c + krow0) * KP + 16 * fq;
        const bf16x8 k00 = *(const LAS bf16x8*)kb, k01 = *(const LAS bf16x8*)(kb + 64), k10 = *(const LAS bf16x8*)(kb + 4 * KP), k11 = *(const LAS bf16x8*)(kb + 4 * KP + 64);
        float s[8]; qk_chunk(s, k00, k01, k10, k11, q0, q1, -mq);
        softmax_pv(st, s, lbase + A_CV + 32 * c * VP + vsub, mq);
    }
    if (LOCAL) {
#pragma unroll
        for (int i = 0; i < 8; ++i) {
            float s[8]; qk_chunk_c(s, kl[i & 3][0][0], kl[i & 3][0][1], kl[i & 3][1][0], kl[i & 3][1][1], q0, q1, bm[i][0], bm[i][1]);
            if (i + 4 < 8) LOADK(i + 4);
            const int slot = (rs + i) % 9;
            softmax_pv(st, s, lbase + A_LV + slot * LV_SLOT + kc0 * VP + vsub, mq);
        }
    }
#undef LOADK
    float l = st.l; l += __shfl_xor(l, 16); l += __shfl_xor(l, 32);
    const float inv = fast_rcp(l);
    bf16_t* op = O + (size_t)(qtok0 + fr) * D + h * 64 + 4 * fq;
#pragma unroll
    for (int db = 0; db < 4; ++db) { const f32x4 o = st.o[db] * inv; u32x2 pk; pk.x = cvt_pk_bf16(o[0], o[1]); pk.y = cvt_pk_bf16(o[2], o[3]); *(u32x2*)(op + 16 * db) = pk; }
}

__device__ __forceinline__ void attn_phase(LAS unsigned char* lds, const bf16_t* QKV, bf16_t* O, const float* rpb, const float* kg, bool ctx_out, int G, int bid, const int tid) {
    const int lane = tid & 63, w = __builtin_amdgcn_readfirstlane(tid >> 6);
    float kmax = fabsf(kg[lane]);
#pragma unroll
    for (int o = 1; o < 64; o <<= 1) kmax = fmaxf(kmax, __shfl_xor(kmax, o));
    kmax *= 8.0f * 1.01f;
    for (int item = bid; item < NB * NH; item += G) {
        const int b = item >> 4, h = item & 15;
        const int ctxrow0 = ML + b * CTX;
        for (int c = tid; c < CTX * 8; c += 512) { const int key = c >> 3, ch = c & 7;
            const bf16_t* src = QKV + (size_t)(ctxrow0 + key) * 3072 + h * 64 + ch * 8;
            const u32x4 kv = *(const u32x4*)(src + 1024), vv = *(const u32x4*)(src + 2048);
            *(LAS u32x4*)(lds + A_CK + key * KP + ch * 16) = kv;
            *(LAS u32x2*)(lds + A_CV + key * VP + ch * 16) = (u32x2){vv.x, vv.y}; *(LAS u32x2*)(lds + A_CV + key * VP + ch * 16 + 8) = (u32x2){vv.z, vv.w}; }
        float bmax = 0.f;
        for (int c = lane; c < 15 * 31; c += 64) bmax = fmaxf(bmax, rpb[h * 15 * 31 + c] * LOG2E);
#pragma unroll
        for (int o = 1; o < 64; o <<= 1) bmax = fmaxf(bmax, __shfl_xor(bmax, o));
        for (int c = tid; c < 15 * 64; c += 512) { const int dr = c >> 6, x = (c & 63) - 16; ((LAS float*)(lds + A_RPB))[c] = (x >= 0 && x < 31) ? rpb[(h * 15 + dr) * 31 + x] * LOG2E : 0.f; }
        const int vkey = tid >> 3, vch = tid & 7;
        const bf16_t* vsrc = QKV + (size_t)(b * SEQ + vkey) * 3072 + 2048 + h * 64 + vch * 8;
        LAS unsigned char* vdst = lds + A_LV + vkey * VP + vch * 16;
        for (int row = 0; row < 8; ++row) { const u32x4 vv = *(const u32x4*)(vsrc + (size_t)row * 64 * 3072);
            LAS unsigned char* dst = vdst + row * LV_SLOT; *(LAS u32x2*)dst = (u32x2){vv.x, vv.y}; *(LAS u32x2*)(dst + 8) = (u32x2){vv.z, vv.w}; }
        int loaded_end = 8;
        for (int it = 0; it < 16; ++it) {
            const int r0 = 2 * it, rsA = min(max(r0 - 4, 0), 24), rsB = min(max(r0 - 3, 0), 24);
            const int next_end = it < 15 ? min(max(r0 - 1, 0), 24) + 8 : loaded_end;
            const int nnew = next_end - loaded_end;
            __syncthreads();
            u32x4 nv0 = (u32x4){0u, 0u, 0u, 0u}, nv1 = nv0;
            if (nnew > 0) nv0 = *(const u32x4*)(vsrc + (size_t)loaded_end * 64 * 3072);
            if (nnew > 1) nv1 = *(const u32x4*)(vsrc + (size_t)(loaded_end + 1) * 64 * 3072);
            { const int ri = w >> 2, j = w & 3, r = r0 + ri, rs = ri ? rsB : rsA;
              attn_unit<true>(lds, QKV, O, b * SEQ + r * 64 + 16 * j, h, b, r, rs, j, lane, kmax, bmax); }
            __syncthreads();
            if (nnew > 0) { LAS unsigned char* dst = vdst + (loaded_end % 9) * LV_SLOT; *(LAS u32x2*)dst = (u32x2){nv0.x, nv0.y}; *(LAS u32x2*)(dst + 8) = (u32x2){nv0.z, nv0.w}; }
            if (nnew > 1) { LAS unsigned char* dst = vdst + ((loaded_end + 1) % 9) * LV_SLOT; *(LAS u32x2*)dst = (u32x2){nv1.x, nv1.y}; *(LAS u32x2*)(dst + 8) = (u32x2){nv1.z, nv1.w}; }
            loaded_end = next_end;
        }
        if (ctx_out) {
            for (int uu = w; uu < 16; uu += 8) attn_unit<false>(lds, QKV, O, ctxrow0 + uu * 16, h, b, 0, 0, 0, lane, kmax, 0.f);
        }
        __syncthreads();
    }
}

#if defined(DBG_ATTN)
__device__ __forceinline__ float bfe(const bf16_t* p, int i) { return __uint_as_float(((unsigned)p[i]) << 16); }
__device__ __forceinline__ void attn_debug(LAS unsigned char* lds, const bf16_t* QKV, bf16_t* O, const float* rpb, bool ctx_out, int G, int bid, const int tid) {
    const int lane = tid & 63, w = tid >> 6;
    LAS float* P = (LAS float*)lds + w * 512;
    const long ntok = ctx_out ? MT : ML;
    for (long it = (long)bid * 8 + w; it < ntok * 16; it += (long)G * 8) {
        const int tok = (int)(it >> 4), h = (int)(it & 15);
        const bool isctx = tok >= ML;
        const int b = isctx ? ((tok - ML) >> 8) : (tok >> 11);
        const int t = tok & 2047, r = t >> 6, col = t & 63, j = col >> 4;
        const int kc0 = min(max(16 * j - 8, 0), 32), rs = min(max(r - 4, 0), 24), cstart = min(max(col - 8, 0), 48);
        const bf16_t* qp = QKV + (size_t)tok * 3072 + h * 64;
        float sc[8]; int kt[8];
#pragma unroll
        for (int k = 0; k < 8; ++k) {
            const int kidx = lane + 64 * (k & 3); bool ok = true; float bias = 0.f; int ktok;
            if (k < 4) { const int i = kidx >> 5, kk = kidx & 31, kcol = kc0 + kk; ktok = b * SEQ + (rs + i) * 64 + kcol; ok = !isctx && kcol >= cstart && kcol < cstart + 16;
                const int dr = rs + i - r + 7, dc = min(max(kcol - col + 15, 0), 30); bias = isctx ? 0.f : rpb[(h * 15 + dr) * 31 + dc] * LOG2E; if (isctx) ktok = ML + b * CTX; }
            else ktok = ML + b * CTX + kidx;
            kt[k] = ktok;
            const bf16_t* kp = QKV + (size_t)ktok * 3072 + 1024 + h * 64; float dot = 0.f;
            for (int d = 0; d < 64; ++d) dot += bfe(qp, d) * bfe(kp, d);
            sc[k] = ok ? dot + bias : -1e30f;
        }
        float m = -1e30f;
#pragma unroll
        for (int k = 0; k < 8; ++k) m = fmaxf(m, sc[k]);
        for (int o = 1; o < 64; o <<= 1) m = fmaxf(m, __shfl_xor(m, o));
        float l = 0.f;
#pragma unroll
        for (int k = 0; k < 8; ++k) { const float p = exp2f(sc[k] - m); l += p; P[k * 64 + lane] = p; }
        l = wave_sum(l);
        float acc = 0.f;
#pragma unroll
        for (int k = 0; k < 8; ++k) for (int ln = 0; ln < 64; ++ln) { const int ktok = __shfl(kt[k], ln); acc += P[k * 64 + ln] * bfe(QKV + (size_t)ktok * 3072 + 2048 + h * 64, lane); }
        O[(size_t)tok * D + h * 64 + lane] = (bf16_t)f2bf(acc / l);
    }
}
#endif
__device__ __forceinline__ void ld8(float (&o)[8], const bf16_t* p);
constexpr int VNP = 264;
__device__ __forceinline__ void spatial_phase(LAS unsigned char* lds, const bf16_t* Z, const float* stats, const float* ln_g, const float* ln_b, const float* w_s, const float* b_s, bf16_t* UM, int G, int bid, const int tid) {
    const int lane = tid & 63, w = __builtin_amdgcn_readfirstlane(tid >> 6), fr = lane & 15, fq = lane >> 4;
    LAS f32x2* ST = (LAS f32x2*)(lds + 128 * VNP);
    const unsigned lbase = (unsigned)(uintptr_t)lds;
    const int p = 16 * w + fr;
    constexpr int NITEM = (MT / 128) * 8;
    f32x4 wa[4][2]; u32x2 ur[8]; float bs = 0.f; u32x4 rawv[4]; f32x4 sp[8];
#define SP_LOAD(it) do { const int n_ = (it) >> 3, g_ = (it) & 7, m0_ = n_ * 128; \
        _Pragma("unroll") for (int ks = 0; ks < 4; ++ks) { const float* wp = w_s + ((size_t)(g_ * 128 + p)) * 128 + 32 * ks + 8 * fq; wa[ks][0] = *(const f32x4*)wp; wa[ks][1] = *(const f32x4*)(wp + 4); } \
        _Pragma("unroll") for (int db = 0; db < 8; ++db) ur[db] = *(const u32x2*)(Z + (size_t)(m0_ + p) * 2048 + g_ * 128 + 16 * db + 4 * fq); \
        bs = b_s[g_ * 128 + p]; \
        _Pragma("unroll") for (int i4 = 0; i4 < 4; ++i4) { const int c = tid + 512 * i4; rawv[i4] = *(const u32x4*)(Z + (size_t)(m0_ + (c >> 4)) * 2048 + 1024 + g_ * 128 + (c & 15) * 8); } \
        if (tid < 128) { const float* spp = stats + (size_t)(m0_ + tid) * 32; _Pragma("unroll") for (int k = 0; k < 8; ++k) sp[k] = *(const f32x4*)(spp + 4 * k); } } while (0)
    if (bid < NITEM) SP_LOAD(bid);
    for (int item = bid; item < NITEM; item += G) {
        const int n = item >> 3, g = item & 7, m0 = n * 128;
        if (tid < 128) { float s = 0.f, ss = 0.f;
#pragma unroll
            for (int k = 0; k < 8; ++k) { s += sp[k][0] + sp[k][2]; ss += sp[k][1] + sp[k][3]; }
            const float mean = s * (1.0f / 1024.0f), var = ss * (1.0f / 1024.0f) - mean * mean;
            ST[tid] = (f32x2){mean, __builtin_amdgcn_rsqf(fmaxf(var, 0.f) + EPS)}; }
        __syncthreads();
#pragma unroll
        for (int i4 = 0; i4 < 4; ++i4) { const int c = tid + 512 * i4; const int q = c >> 4, ch = c & 15;
            const u32x4 raw = rawv[i4];
            const f32x2 st = ST[q];
            const float* gp = ln_g + g * 128 + ch * 8; const float* bp = ln_b + g * 128 + ch * 8;
            const f32x4 g0 = *(const f32x4*)gp, g1 = *(const f32x4*)(gp + 4), b0 = *(const f32x4*)bp, b1 = *(const f32x4*)(bp + 4);
            float o[8];
            o[0] = (bf_lo(raw.x) - st.x) * st.y * g0[0] + b0[0]; o[1] = (bf_hi(raw.x) - st.x) * st.y * g0[1] + b0[1];
            o[2] = (bf_lo(raw.y) - st.x) * st.y * g0[2] + b0[2]; o[3] = (bf_hi(raw.y) - st.x) * st.y * g0[3] + b0[3];
            o[4] = (bf_lo(raw.z) - st.x) * st.y * g1[0] + b1[0]; o[5] = (bf_hi(raw.z) - st.x) * st.y * g1[1] + b1[1];
            o[6] = (bf_lo(raw.w) - st.x) * st.y * g1[2] + b1[2]; o[7] = (bf_hi(raw.w) - st.x) * st.y * g1[3] + b1[3];
            LAS unsigned char* dst = lds + q * VNP + ch * 16;
            *(LAS u32x2*)dst = (u32x2){cvt_pk_bf16(o[0], o[1]), cvt_pk_bf16(o[2], o[3])}; *(LAS u32x2*)(dst + 8) = (u32x2){cvt_pk_bf16(o[4], o[5]), cvt_pk_bf16(o[6], o[7])}; }
        bf16x8 wf[4];
#pragma unroll
        for (int ks = 0; ks < 4; ++ks) { u32x4 pw; pw.x = cvt_pk_bf16(wa[ks][0][0], wa[ks][0][1]); pw.y = cvt_pk_bf16(wa[ks][0][2], wa[ks][0][3]); pw.z = cvt_pk_bf16(wa[ks][1][0], wa[ks][1][1]); pw.w = cvt_pk_bf16(wa[ks][1][2], wa[ks][1][3]); wf[ks] = __builtin_bit_cast(bf16x8, pw); }
        u32x2 urc[8];
#pragma unroll
        for (int db = 0; db < 8; ++db) urc[db] = ur[db];
        const float bsc = bs;
        __syncthreads();
        if (item + G < NITEM) SP_LOAD(item + G);
        const unsigned vsub = lbase + (unsigned)((8 * fq + (fr >> 2)) * VNP + 8 * (fr & 3));
#pragma unroll
        for (int db = 0; db < 8; ++db) {
            f32x4 acc = (f32x4){0.f, 0.f, 0.f, 0.f};
#pragma unroll
            for (int ks = 0; ks < 4; ++ks) {
                const s16x4 lo = vtr(vsub + 32 * ks * VNP + db * 32), hi = vtr(vsub + (32 * ks + 4) * VNP + db * 32);
                const bf16x8 vf = (bf16x8){lo[0], lo[1], lo[2], lo[3], hi[0], hi[1], hi[2], hi[3]};
                acc = __builtin_amdgcn_mfma_f32_16x16x32_bf16(vf, wf[ks], acc, 0, 0, 0);
            }
            u32x2 pk; pk.x = cvt_pk_bf16(bf_lo(urc[db].x) * (acc[0] + bsc), bf_hi(urc[db].x) * (acc[1] + bsc)); pk.y = cvt_pk_bf16(bf_lo(urc[db].y) * (acc[2] + bsc), bf_hi(urc[db].y) * (acc[3] + bsc));
            *(u32x2*)(UM + (size_t)(m0 + p) * D + g * 128 + 16 * db + 4 * fq) = pk;
        }
        __syncthreads();
    }
#undef SP_LOAD
}

__device__ __forceinline__ void ld8(float (&o)[8], const bf16_t* p) { const u32x4 r = *(const u32x4*)p; o[0] = bf_lo(r.x); o[1] = bf_hi(r.x); o[2] = bf_lo(r.y); o[3] = bf_hi(r.y); o[4] = bf_lo(r.z); o[5] = bf_hi(r.z); o[6] = bf_lo(r.w); o[7] = bf_hi(r.w); }
__device__ __forceinline__ void ld8l(float (&o)[8], const LAS unsigned char* p) { const u32x4 r = *(const LAS u32x4*)p; o[0] = bf_lo(r.x); o[1] = bf_hi(r.x); o[2] = bf_lo(r.y); o[3] = bf_hi(r.y); o[4] = bf_lo(r.z); o[5] = bf_hi(r.z); o[6] = bf_lo(r.w); o[7] = bf_hi(r.w); }
__device__ __forceinline__ void pooldiff_phase(LAS unsigned char* lds, const bf16_t* H, bf16_t* PD, int G, int bid, const int tid) {
    for (int item = bid; item < MT / 32; item += G) {
        const int m0 = item * 32;
        int seq0, L;
        if (m0 < ML) { seq0 = (m0 >> 11) << 11; L = SEQ; } else { seq0 = ML + (((m0 - ML) >> 8) << 8); L = CTX; }
        const int t0 = m0 - seq0, lo_t = max(t0 - 8, 0), hi_t = min(t0 + 40, L), ncell = (hi_t - lo_t) * 128;
        u32x4 tmp[12];
#pragma unroll
        for (int i = 0; i < 12; ++i) { const int c = tid + 512 * i; if (c < ncell) tmp[i] = *(const u32x4*)(H + (size_t)(seq0 + lo_t + (c >> 7)) * D + (c & 127) * 8); }
#pragma unroll
        for (int i = 0; i < 12; ++i) { const int c = tid + 512 * i; if (c < ncell) *(LAS u32x4*)(lds + (lo_t + (c >> 7) - (t0 - 8)) * 2048 + (c & 127) * 16) = tmp[i]; }
        __syncthreads();
        const int ch = tid & 127, tb = t0 + (tid >> 7) * 8, g = ch >> 5, wdw = 2 << g, half = wdw >> 1;
        const LAS unsigned char* lb = lds + ch * 16; const int rb = t0 - 8;
        bf16_t* ob = PD + (size_t)seq0 * D + ch * 8;
        float acc[8];
#pragma unroll
        for (int e = 0; e < 8; ++e) acc[e] = 0.f;
        int lo = max(tb - half, 0), hi = min(tb - half + wdw, L);
        for (int t = lo; t < hi; ++t) { float v[8]; ld8l(v, lb + (t - rb) * 2048);
#pragma unroll
            for (int e = 0; e < 8; ++e) acc[e] += v[e]; }
#pragma unroll
        for (int k = 0; k < 8; ++k) {
            const int t = tb + k; float own[8]; ld8l(own, lb + (t - rb) * 2048);
            const float ic = 1.0f / (float)(hi - lo);
            u32x4 w; w.x = cvt_pk_bf16(acc[0] * ic - own[0], acc[1] * ic - own[1]); w.y = cvt_pk_bf16(acc[2] * ic - own[2], acc[3] * ic - own[3]);
            w.z = cvt_pk_bf16(acc[4] * ic - own[4], acc[5] * ic - own[5]); w.w = cvt_pk_bf16(acc[6] * ic - own[6], acc[7] * ic - own[7]);
            *(u32x4*)(ob + (size_t)t * D) = w;
            const int nlo = max(t + 1 - half, 0), nhi = min(t + 1 - half + wdw, L);
            if (nhi > hi) { float v[8]; ld8l(v, lb + (hi - rb) * 2048);
#pragma unroll
                for (int e = 0; e < 8; ++e) acc[e] += v[e]; }
            if (nlo > lo) { float v[8]; ld8l(v, lb + (lo - rb) * 2048);
#pragma unroll
                for (int e = 0; e < 8; ++e) acc[e] -= v[e]; }
            lo = nlo; hi = nhi;
        }
        __syncthreads();
    }
}

constexpr size_t WS_BAR = 0x1F0000;
constexpr int MISC_OFF = LDS_BYTES - 64;
#define XB_TMO      128
#define XB_XCNT(j)  (256  + 64 * (j))
#define XB_XSUB(j)  (1280 + 64 * (j))
#define XB_XGEN(j)  (2304 + 64 * (j))
#define XB_TOP      3328
#define XB_TOPGEN   3392
#define XCD_BAR_WORDS 3456
#define XB_SPIN_CAP (1u << 18)

__device__ __forceinline__ unsigned xb_ld(unsigned* p)              { return __hip_atomic_load(p, __ATOMIC_RELAXED, __HIP_MEMORY_SCOPE_AGENT); }
__device__ __forceinline__ unsigned xb_add(unsigned* p, unsigned v) { return __hip_atomic_fetch_add(p, v, __ATOMIC_RELAXED, __HIP_MEMORY_SCOPE_AGENT); }
__device__ __forceinline__ unsigned xb_xcc_id() { return (unsigned)__builtin_amdgcn_s_getreg((3 << 11) | 20) & 0xFu; }
#define XB_SPIN(cond, bar) do { unsigned _sp = 0; while (cond) {   \
    if ((++_sp & 255u) == 0u) { if (xb_ld(&(bar)[XB_TMO])) break; if (_sp > XB_SPIN_CAP) { atomicAdd(&(bar)[XB_TMO], 1u); break; } } } } while (0)

struct XcdBarrier {
    unsigned* bar; unsigned x;
    volatile LAS unsigned* st;
};

__device__ __forceinline__ XcdBarrier xcd_barrier_post(unsigned* bar, volatile LAS unsigned* st) {
    XcdBarrier b; b.bar = bar; b.x = xb_xcc_id(); b.st = st;
    if (threadIdx.x == 0) (void)xb_add(&bar[XB_XCNT(b.x)], 1u);
    return b;
}
__device__ __forceinline__ void xcd_barrier_complete(unsigned* bar, unsigned x, unsigned& nloc, unsigned& nx) {
    const unsigned G = gridDim.x * gridDim.y * gridDim.z;
    unsigned sum, cnt, mine, sp = 0u;
    for (;;) {
        sum = 0u; cnt = 0u; mine = 0u;
#pragma unroll
        for (unsigned j = 0; j < 16; ++j) { const unsigned c = xb_ld(&bar[XB_XCNT(j)]); sum += c; cnt += (c > 0u) ? 1u : 0u; mine = (j == x) ? c : mine; }
        if (sum == G) break;
        __builtin_amdgcn_s_sleep(1);
        if ((++sp & 255u) == 0u) { if (xb_ld(&bar[XB_TMO])) break; if (sp > XB_SPIN_CAP) { atomicAdd(&bar[XB_TMO], 1u); break; } }
    }
    nloc = mine > 0u ? mine : 1u; nx = cnt > 0u ? cnt : 1u;
}

__device__ __forceinline__ void xcd_barrier(const XcdBarrier& b) {
    asm volatile("s_waitcnt vmcnt(0)" ::: "memory");
    __syncthreads();
    if (threadIdx.x == 0) {
        unsigned* bar = b.bar;
        __builtin_amdgcn_s_waitcnt(0);
        unsigned nloc = b.st[0], nx = b.st[1];
        if (nloc == 0u) { xcd_barrier_complete(bar, b.x, nloc, nx); b.st[0] = nloc; b.st[1] = nx; }
        const unsigned old = xb_add(&bar[XB_XSUB(b.x)], 1u);
        const unsigned gen = old / nloc;
        if (old + 1u == (gen + 1u) * nloc) {
            __builtin_amdgcn_fence(__ATOMIC_RELEASE, "agent");
            asm volatile("s_waitcnt vmcnt(0)" ::: "memory");
            const unsigned og = xb_add(&bar[XB_TOP], 1u);
            const unsigned tg = og / nx;
            if (og + 1u == (tg + 1u) * nx) xb_add(&bar[XB_TOPGEN], 1u);
            else XB_SPIN(xb_ld(&bar[XB_TOPGEN]) == tg, bar);
            __builtin_amdgcn_fence(__ATOMIC_ACQUIRE, "agent");
            xb_add(&bar[XB_XGEN(b.x)], 1u);
            asm volatile("s_waitcnt vmcnt(0)" ::: "memory");
        } else {
            XB_SPIN(xb_ld(&bar[XB_XGEN(b.x)]) == gen, bar);
            __builtin_amdgcn_fence(__ATOMIC_ACQUIRE, "agent");
            asm volatile("s_waitcnt vmcnt(0)" ::: "memory");
        }
    }
    __syncthreads();
}


constexpr int NPHASES = 28;
enum { OP_P0 = 0, OP_NORM1, OP_QKV, OP_ATTN, OP_WO, OP_WIN, OP_SPATIAL, OP_WOUT, OP_POOLDIFF, OP_POOLGEMM, OP_NORM2, OP_GU, OP_DOWN };
__constant__ unsigned char PH_OP[NPHASES] = { OP_P0,
    OP_NORM1, OP_QKV, OP_ATTN, OP_WO, OP_NORM2, OP_GU, OP_DOWN,
    OP_NORM1, OP_WIN, OP_SPATIAL, OP_WOUT, OP_NORM2, OP_GU, OP_DOWN,
    OP_NORM1, OP_POOLDIFF, OP_POOLGEMM, OP_NORM2, OP_GU, OP_DOWN,
    OP_NORM1, OP_QKV, OP_ATTN, OP_WO, OP_NORM2, OP_GU, OP_DOWN };
__constant__ unsigned char PH_LAYER[NPHASES] = { 0, 0, 0, 0, 0, 0, 0, 0, 1, 1, 1, 1, 1, 1, 1, 2, 2, 2, 2, 2, 2, 3, 3, 3, 3, 3, 3, 3 };
#ifndef PH_MASK
#define PH_MASK 0xffff
#endif
#define OPON(bit) ((PH_MASK >> (bit)) & 1)

__global__ void __launch_bounds__(512, 2) mk_fwd(Args a) {
    extern __shared__ __attribute__((aligned(16))) unsigned char lds_raw[];
    LAS unsigned char* lds = (LAS unsigned char*)lds_raw;
#if !MK_MULTI
    cg::grid_group grid = cg::this_grid();
    volatile LAS unsigned* MISC = (volatile LAS unsigned*)(lds + MISC_OFF);
    if (threadIdx.x < 16) MISC[threadIdx.x] = 0u;
    __syncthreads();
    (void)xcd_barrier_post((unsigned*)(a.ws + WS_BAR), MISC);
#endif
#ifndef DUP_OP
#define DUP_OP 99
#endif
    for (int ph = a.ph_lo, rep = 0; ph < a.ph_hi; ++ph) {
        int tid = threadIdx.x, bid = blockIdx.x, G = gridDim.x; asm volatile("" : "+v"(tid)); asm volatile("" : "+s"(bid), "+s"(G));
        ArgsP ap = (ArgsP)__builtin_amdgcn_kernarg_segment_ptr(); asm volatile("" : "+s"(ap));
        unsigned char* ws = ap->ws;
        const int op = PH_OP[ph], layer = PH_LAYER[ph], j = layer / 3; const bool last = layer == 3;
        float* MOD = (float*)(ws + WS_MOD); float* STATS = (float*)(ws + WS_STATS);
        float* XL = ap->out; float* XC = (float*)(ws + WS_XCTX) - (size_t)ML * D;
        bf16_t* Hb = (bf16_t*)(ws + WS_H); bf16_t* Ob = (bf16_t*)(ws + WS_O); bf16_t* BIG = (bf16_t*)(ws + WS_BIG);
        const float* modl = MOD + (size_t)layer * 17 * MODW;
        const float* xin_l = layer == 0 ? ap->in[I_X] : XL; const float* xin_c = layer == 0 ? ap->in[I_CTX] - (size_t)ML * D : XC;
        const int Mrows = last ? ML : MT;
        pg8::StaticOrder S;
        if (op == OP_P0) { if (OPON(0)) p0_prologue(ap, lds, G, bid, tid); }
        else if (op == OP_NORM1 || op == OP_NORM2) {
            if (OPON(1)) { const bool n1 = op == OP_NORM1;
                norm_phase(n1 ? xin_l : XL, n1 ? xin_c : XC, ap->in[n1 ? I_N1G : I_N2G] + layer * D, modl, n1 ? 0 : 3 * D, n1 ? D : 4 * D, Hb, n1 ? MT : Mrows, G, bid, tid, (n1 && layer == 0) ? XL : nullptr, XC,
                           n1 ? (layer > 0 ? (const float*)Ob : nullptr) : ((layer < 2) ? (const float*)BIG : nullptr)); }
        } else if (op == OP_QKV) {
            if (OPON(2)) { pg8::Gemm g{Hb, (const bf16_t*)(ws + WS_WQKV) + (size_t)j * 3072 * D, MT, 3072, D, D, 0}; S.init(MT, 3072, D, G, bid);
                EpiQKV E{BIG, ap->in[I_QN] + j * HD, ap->in[I_KN] + j * HD}; pg8::gemm_phase<EpiQKV>(lds, g, S, E, tid); }
        } else if (op == OP_ATTN) {
#if defined(DBG_ATTN)
            if (OPON(3)) attn_debug(lds, BIG, Ob, ap->in[I_RPB] + (size_t)j * NH * 15 * 31, !last, G, bid, tid);
#else
            if (OPON(3)) attn_phase(lds, BIG, Ob, ap->in[I_RPB] + (size_t)j * NH * 15 * 31, ap->in[I_KN] + j * HD, !last, G, bid, tid);
#endif
        } else if (op == OP_WIN) {
            if (OPON(5)) { pg8::Gemm g{Hb, (const bf16_t*)(ws + WS_WIN), MT, 2048, D, D, 0}; S.init(MT, 2048, D, G, bid);
                EpiGelu E{BIG, ap->in[I_GBIN], STATS}; pg8::gemm_phase<EpiGelu>(lds, g, S, E, tid); }
        } else if (op == OP_SPATIAL) {
            if (OPON(6)) spatial_phase(lds, BIG, STATS, ap->in[I_GLNG], ap->in[I_GLNB], ap->in[I_GWS], ap->in[I_GBS], Ob, G, bid, tid);
        } else if (op == OP_POOLDIFF) {
            if (OPON(7)) pooldiff_phase(lds, Hb, Ob, G, bid, tid);
        } else if (op == OP_GU) {
            if (OPON(8)) { pg8::Gemm g{Hb, (const bf16_t*)(ws + WS_WGU) + (size_t)layer * 2 * FF * D, Mrows, 2 * FF, D, D, 0}; S.init(Mrows, 2 * FF, D, G, bid);
                EpiSwiGLU E{BIG}; pg8::gemm_phase<EpiSwiGLU>(lds, g, S, E, tid); }
        } else {
            if (OPON(4)) {
                pg8::Gemm g{Ob, nullptr, Mrows, D, D, D, 0};
                EpiResid E{XL, XC, XL, XC, modl + 2 * D, nullptr, (float*)BIG};
                if (op == OP_WO) g.Bt = (const bf16_t*)(ws + WS_WO) + (size_t)j * D * D;
                else if (op == OP_WOUT) g.Bt = (const bf16_t*)(ws + WS_WOUT);
                else if (op == OP_POOLGEMM) { g.Bt = (const bf16_t*)(ws + WS_WPOOL); g.K = 256; g.a_pn_off = 512; E.cscale = ap->in[I_PS]; }
                else { g.A = BIG; g.Bt = (const bf16_t*)(ws + WS_WDN) + (size_t)layer * D * FF; g.K = FF; g.lda = FF; E.mod = modl + 5 * D; E.part = (float*)Ob; }
                if (op != OP_POOLGEMM && Mrows == MT) S.init(ML, D, g.K, G, bid, MC);
                else S.init(Mrows, D, g.K, G, bid);
                pg8::gemm_phase<EpiResid>(lds, g, S, E, tid);
            }
        }
#if !MK_MULTI
        if (ph + 1 < a.ph_hi) { if (a.ph_hi > 1000000) grid.sync(); else { XcdBarrier xb; xb.bar = (unsigned*)(ap->ws + WS_BAR); xb.x = xb_xcc_id(); xb.st = (volatile LAS unsigned*)(lds + MISC_OFF); xcd_barrier(xb); } }
#endif
        if (PH_OP[ph] == DUP_OP && rep == 0) { rep = 1; --ph; } else rep = 0;
    }
}


#if defined(DBG_CHECK)
constexpr size_t WS_FLAGS = WS_END, WS_EXP = WS_END + 4096;
constexpr int NSAMP = 4096;
__device__ __forceinline__ float rbf(float x) { return __uint_as_float(f2bf(x) << 16); }
__device__ __forceinline__ float bfv(const bf16_t* p, size_t i) { return __uint_as_float(((unsigned)p[i]) << 16); }
__device__ __forceinline__ unsigned hash32(unsigned x) { x ^= x >> 16; x *= 0x7feb352dU; x ^= x >> 15; x *= 0x846ca68bU; x ^= x >> 16; return x; }
__global__ void chk_kernel(Args a, int ph, int mode) {
    const int s = blockIdx.x * blockDim.x + threadIdx.x; if (s >= NSAMP) return;
    unsigned char* ws = a.ws; unsigned* FLAGS = (unsigned*)(ws + WS_FLAGS); float* EXP = (float*)(ws + WS_EXP);
    const int op = PH_OP[ph], layer = PH_LAYER[ph], j = layer / 3; const bool last = layer == 3;
    float* MOD = (float*)(ws + WS_MOD);
    float* XL = a.out; float* XC = (float*)(ws + WS_XCTX) - (size_t)ML * D;
    bf16_t* Hb = (bf16_t*)(ws + WS_H); bf16_t* Ob = (bf16_t*)(ws + WS_O); bf16_t* BIG = (bf16_t*)(ws + WS_BIG);
    const float* modl = MOD + (size_t)layer * 17 * MODW;
    const float* xin_l = layer == 0 ? a.in[I_X] : XL; const float* xin_c = layer == 0 ? a.in[I_CTX] - (size_t)ML * D : XC;
    const int Mrows = last ? ML : MT;
    const unsigned h1 = hash32(s * 2654435761u + ph * 97u + 1u), h2 = hash32(h1 + 0x9e3779b9u);
    bool bad = false;
#define cmp(got, want) do { const float w_ = (want); const float e_ = fabsf((got) - w_); if (!(e_ <= 0.02f + 0.02f * fabsf(w_))) bad = true; } while (0)
    if (op == OP_NORM1 || op == OP_NORM2) { if (mode == 0) return;
        const bool n1 = op == OP_NORM1; const int rows = n1 ? MT : Mrows; const int m = h1 % rows, c = h2 % D;
        const float* xr = (m < ML ? (n1 ? xin_l : XL) : (n1 ? xin_c : XC)) + (size_t)m * D; float ss = 0.f; for (int k = 0; k < D; ++k) ss += xr[k] * xr[k];
        const float* mp = modl + (size_t)(m < ML ? (m >> 11) : NB) * MODW; const float g = a.in[n1 ? I_N1G : I_N2G][layer * D + c];
        const float want = xr[c] * rsqrtf(ss / D + EPS) * g * (1.f + mp[(n1 ? D : 4 * D) + c]) + mp[(n1 ? 0 : 3 * D) + c];
        cmp(bfv(Hb, (size_t)m * D + c), want);
    } else if (op == OP_QKV) { if (mode == 0) return;
        const int m = h1 % MT, hd48 = h2 % 48, kind = hd48 / 16; const float* W = a.in[I_WQKV] + (size_t)j * D * 3072; float ss = 0.f;
        for (int d = 0; d < 64; ++d) { float acc = 0.f; for (int k = 0; k < D; ++k) acc += bfv(Hb, (size_t)m * D + k) * rbf(W[(size_t)k * 3072 + hd48 * 64 + d]); ss += acc * acc; }
        const float rs = rsqrtf(ss / 64.f + EPS);
        for (int d = 0; d < 64; ++d) { float acc = 0.f; for (int k = 0; k < D; ++k) acc += bfv(Hb, (size_t)m * D + k) * rbf(W[(size_t)k * 3072 + hd48 * 64 + d]);
            float want = acc; if (kind == 0) want = acc * rs * a.in[I_QN][j * 64 + d] * QSCALE; else if (kind == 1) want = acc * rs * a.in[I_KN][j * 64 + d];
            cmp(bfv(BIG, (size_t)m * 3072 + hd48 * 64 + d), want); }
    } else if (op == OP_WIN) { if (mode == 0) return;
        const int m = h1 % MT, c = h2 % 2048; float acc = 0.f; for (int k = 0; k < D; ++k) acc += bfv(Hb, (size_t)m * D + k) * rbf(a.in[I_GWIN][(size_t)k * 2048 + c]);
        const float x = acc + a.in[I_GBIN][c]; const float want = 0.5f * x * (1.f + tanhf(0.7978845608f * (x + 0.044715f * x * x * x)));
        cmp(bfv(BIG, (size_t)m * 2048 + c), want);
    } else if (op == OP_GU) { if (mode == 0) return;
        const int m = h1 % Mrows, c = h2 % FF; float ag = 0.f, au = 0.f; const float* Wg = a.in[I_WG] + (size_t)layer * D * FF; const float* Wu = a.in[I_WU] + (size_t)layer * D * FF;
        for (int k = 0; k < D; ++k) { const float hv = bfv(Hb, (size_t)m * D + k); ag += hv * rbf(Wg[(size_t)k * FF + c]); au += hv * rbf(Wu[(size_t)k * FF + c]); }
        cmp(bfv(BIG, (size_t)m * FF + c), ag / (1.f + expf(-ag)) * au);
    } else if (op == OP_WO || op == OP_WOUT || op == OP_POOLGEMM || op == OP_DOWN) {
        const int m = h1 % Mrows, c = h2 % D; const bool lat = m < ML;
        if (mode == 0) {
            float acc = 0.f;
            if (op == OP_WO) { const float* W = a.in[I_WO] + (size_t)j * D * D; for (int k = 0; k < D; ++k) acc += bfv(Ob, (size_t)m * D + k) * rbf(W[(size_t)k * D + c]); }
            else if (op == OP_WOUT) { for (int k = 0; k < D; ++k) acc += bfv(Ob, (size_t)m * D + k) * rbf(a.in[I_GWOUT][(size_t)k * D + c]); }
            else if (op == OP_POOLGEMM) { const int g = c >> 8; for (int k = 0; k < 256; ++k) acc += bfv(Ob, (size_t)m * D + g * 256 + k) * rbf(a.in[I_PW][((size_t)g * 256 + k) * 256 + (c & 255)]); acc *= a.in[I_PS][c]; }
            else { const float* W = a.in[I_WD] + (size_t)layer * FF * D; for (int k = 0; k < FF; ++k) acc += bfv(BIG, (size_t)m * FF + k) * rbf(W[(size_t)k * D + c]); }
            const float gate = modl[(size_t)(lat ? (m >> 11) : NB) * MODW + (op == OP_DOWN ? 5 * D : 2 * D) + c];
            const float base = (lat ? XL : XC)[(size_t)m * D + c];
            EXP[s] = base + gate * acc; if (ph == 7) EXP[NSAMP + s] = (lat ? a.in[I_X][(size_t)m * D + c] : a.in[I_CTX][(size_t)(m - ML) * D + c]) + gate * acc;
        } else { cmp((lat ? XL : XC)[(size_t)m * D + c], EXP[s]); if (ph == 7) { if (fabsf((lat ? XL : XC)[(size_t)m * D + c] - EXP[NSAMP + s]) < 0.01f) atomicAdd(FLAGS + 102, 1u); atomicAdd((float*)(FLAGS + 100), fabsf((lat ? XL : XC)[(size_t)m * D + c] - EXP[s])); if (!lat) atomicAdd((float*)(FLAGS + 101), fabsf(XC[(size_t)m * D + c] - EXP[s])); } }
    } else if (op == OP_SPATIAL) { if (mode == 0) return;
        const int m = h1 % MT, c = h2 % D, g = c >> 7, m0 = m & ~127, p = m & 127; float acc = 0.f;
        for (int q = 0; q < 128; ++q) { const bf16_t* zr = BIG + (size_t)(m0 + q) * 2048 + 1024; float su = 0.f, sq = 0.f; for (int k = 0; k < 1024; ++k) { const float x = bfv(zr, k); su += x; sq += x * x; }
            const float mean = su / 1024.f, var = sq / 1024.f - mean * mean; const float vn = (bfv(zr, c) - mean) * rsqrtf(var + EPS) * a.in[I_GLNG][c] + a.in[I_GLNB][c];
            acc += a.in[I_GWS][((size_t)g * 128 + p) * 128 + q] * vn; }
        cmp(bfv(Ob, (size_t)m * D + c), bfv(BIG, (size_t)m * 2048 + c) * (acc + a.in[I_GBS][g * 128 + p]));
    } else if (op == OP_POOLDIFF) { if (mode == 0) return;
        const int m = h1 % MT, c = h2 % D, g = c >> 8, w = 2 << g; int seq0, L; if (m < ML) { seq0 = m & ~2047; L = SEQ; } else { seq0 = ML + ((m - ML) & ~255); L = CTX; }
        const int t = m - seq0, lo = max(t - w / 2, 0), hi = min(t - w / 2 + w, L); float su = 0.f; for (int tt = lo; tt < hi; ++tt) su += bfv(Hb, (size_t)(seq0 + tt) * D + c);
        cmp(bfv(Ob, (size_t)m * D + c), su / (hi - lo) - bfv(Hb, (size_t)m * D + c));
    } else if (op == OP_P0) { if (mode == 0) return;
        const int i = s & 3, c = h1 % D, k = h2 % FF;
        const bf16_t* WT = (const bf16_t*)(ws + WS_WDN) + (size_t)i * D * FF; const float* W = a.in[I_WD] + (size_t)i * FF * D;
        cmp(bfv(WT, (size_t)c * FF + k), rbf(W[(size_t)k * D + c]));
    } else return;
    if (bad) atomicAdd(FLAGS + ph, 1u);
}
__global__ void chk_report(Args a) {
    unsigned* FLAGS = (unsigned*)(a.ws + WS_FLAGS);
    for (int ph = 0; ph < NPHASES; ++ph) if (FLAGS[ph] > 0) { a.out[0] += 1000.f * (ph + 1) + (FLAGS[ph] > 100 ? 500.f : 0.f); return; }
}
#endif

extern "C" void kernel_launch(void* const* d_in, const int* in_sizes, int n_in, void* d_out, int out_size, void* d_ws, size_t ws_size, hipStream_t stream) {
    static int grid = 0;
    if (grid == 0) {
        if (n_in != 25 || out_size != ML * D || ws_size < WS_END) { fprintf(stderr, "kernel_launch: unexpected problem (n_in %d, out %d, ws %zu); nothing launched\n", n_in, out_size, ws_size); grid = -1; return; }
        int dev = 0, cus = 0, per_cu = 0;
        hipGetDevice(&dev); hipDeviceGetAttribute(&cus, hipDeviceAttributeMultiprocessorCount, dev);
        hipFuncSetAttribute((const void*)mk_fwd, hipFuncAttributeMaxDynamicSharedMemorySize, LDS_BYTES);
        hipOccupancyMaxActiveBlocksPerMultiprocessor(&per_cu, (const void*)mk_fwd, 512, LDS_BYTES);
        if (per_cu < 1) { fprintf(stderr, "kernel_launch: occupancy query says %d blocks per CU\n", per_cu); per_cu = 1; }
        (void)hipGetLastError();
        grid = cus * 1;
    }
    if (grid < 0) return;
    Args a{};
    for (int i = 0; i < 25; ++i) a.in[i] = (const float*)d_in[i];
    a.out = (float*)d_out; a.ws = (unsigned char*)d_ws;
#if MK_MULTI
#if defined(DBG_CHECK)
    hipMemsetAsync((char*)d_ws + WS_FLAGS, 0, 4096, stream);
#endif
    for (int p = 0; p < NPHASES; ++p) { a.ph_lo = p; a.ph_hi = p + 1;
#if defined(DBG_CHECK)
        hipLaunchKernelGGL(chk_kernel, dim3(NSAMP / 256), dim3(256), 0, stream, a, p, 0);
#endif
        hipLaunchKernelGGL(mk_fwd, dim3(grid), dim3(512), LDS_BYTES, stream, a);
#if defined(DBG_CHECK)
        hipLaunchKernelGGL(chk_kernel, dim3(NSAMP / 256), dim3(256), 0, stream, a, p, 1);
#endif
    }
#if defined(DBG_CHECK)
    hipLaunchKernelGGL(chk_report, dim3(1), dim3(1), 0, stream, a);
#endif
#else
    a.ph_lo = 0; a.ph_hi = NPHASES;
    hipMemsetAsync((char*)d_ws + WS_BAR, 0, 16384, stream);
    void* args[] = {&a};
    hipError_t e = hipLaunchCooperativeKernel((const void*)mk_fwd, dim3(grid), dim3(512), args, LDS_BYTES, stream);
    if (e != hipSuccess) fprintf(stderr, "cooperative launch failed: %s (grid %d)\n", hipGetErrorString(e), grid);
#endif
}
```
